# Optimizing an MI355X kernel written in HIP

```python
import jax, jax.numpy as jnp
from jax import lax
import numpy as np

D_MODEL = 1024
BATCH = 4
SEQ = 4096
DEPTH = 1

CHUNK = 64
N_MEM = 256
DN_HEADS = 4
DN_HEAD_DIM = 128
DN_WIDTH = DN_HEADS * DN_HEAD_DIM
CONV_K = 4
POOL_GROUPS = 4
POOL_WINDOWS = (2, 4, 8, 16)
POOL_WIDTH = D_MODEL // 2
POOL_GROUP_DIM = POOL_WIDTH // POOL_GROUPS
D_FF = 2816
XA_HEADS = 4
XA_HEAD_DIM = D_MODEL // XA_HEADS
LN_EPS = 1e-5
RMS_EPS = 1e-6
L2_EPS = 1e-6
ALPHA = (2.0 * DEPTH) ** 0.25
BETA_INIT = (8.0 * DEPTH) ** -0.25

OFF_QKV = 3 * DN_WIDTH
OFF_Z = OFF_QKV + DN_WIDTH
OFF_A = OFF_Z + DN_HEADS
OFF_B = OFF_A + DN_HEADS
OFF_POOL = OFF_B + POOL_WIDTH
OFF_GDN = OFF_POOL + D_MODEL
IN_COLS = OFF_GDN + D_MODEL
IN_SPLITS = (OFF_QKV, OFF_Z, OFF_A, OFF_B, OFF_POOL, OFF_GDN)

kernel_name = "hybrid_deltanet_pool_macaron_deepnorm"


def _layernorm(x, g, b):
    xf = x.astype(jnp.float32)
    mu = jnp.mean(xf, axis=-1, keepdims=True)
    var = jnp.mean(jnp.square(xf - mu), axis=-1, keepdims=True)
    y = (xf - mu) * lax.rsqrt(var + LN_EPS) * g.astype(jnp.float32) + b.astype(jnp.float32)
    return y.astype(x.dtype)


def _swiglu(x, w_gate, w_up, w_down):
    return (jax.nn.silu(x @ w_gate) * (x @ w_up)) @ w_down


def _causal_dwconv(x, w):
    c = x.shape[-1]
    return lax.conv_general_dilated(
        x, w[:, None, :].astype(x.dtype), window_strides=(1,), padding=[(CONV_K - 1, 0)],
        dimension_numbers=("NWC", "WIO", "NWC"), feature_group_count=c)


def _l2norm(x):
    return x * lax.rsqrt(jnp.sum(jnp.square(x), axis=-1, keepdims=True) + L2_EPS)


def _gated_delta_rule(q, k, v, g, beta):
    B, L, H, D = q.shape
    n = L // CHUNK
    ch = lambda t: t.reshape(B, n, CHUNK, H, D).transpose(1, 0, 3, 2, 4)
    q, k, v = ch(q), ch(k), ch(v)
    g = g.reshape(B, n, CHUNK, H).transpose(1, 0, 3, 2)
    beta = beta.reshape(B, n, CHUNK, H).transpose(1, 0, 3, 2)

    gc = jnp.cumsum(g, axis=-1)
    idx = jnp.arange(CHUNK)
    incl = idx[:, None] >= idx[None, :]
    strict = idx[:, None] > idx[None, :]
    diff = gc[..., :, None] - gc[..., None, :]
    decay = jnp.exp(jnp.where(incl, diff, -jnp.inf))

    kb = k * beta[..., None]
    a_low = jnp.where(strict, jnp.einsum("nbhcd,nbhed->nbhce", kb, k) * decay, 0.0)
    eye = jnp.eye(CHUNK, dtype=jnp.float32)
    rhs = jnp.concatenate([v * beta[..., None], kb * jnp.exp(gc)[..., None]], axis=-1)
    sol = lax.linalg.triangular_solve(a_low + eye, rhs, left_side=True, lower=True,
                                      unit_diagonal=True)
    u, w = sol[..., :D], sol[..., D:]

    attn = jnp.einsum("nbhcd,nbhed->nbhce", q, k) * decay
    q_dec = q * jnp.exp(gc)[..., None]
    g_last = gc[..., -1]
    k_dec = k * jnp.exp(g_last[..., None] - gc)[..., None]

    def step(state, inp):
        qd, kd, ui, wi, ai, gl = inp
        v_new = ui - jnp.einsum("bhcd,bhde->bhce", wi, state)
        o = jnp.einsum("bhcd,bhde->bhce", qd, state) + jnp.einsum("bhce,bhef->bhcf", ai, v_new)
        state = state * jnp.exp(gl)[..., None, None] + jnp.einsum("bhcd,bhce->bhde", kd, v_new)
        return state, o

    s0 = jnp.zeros((B, H, D, D), jnp.float32)
    _, o = lax.scan(step, s0, (q_dec, k_dec, u, w, attn, g_last))
    return o.transpose(1, 0, 3, 2, 4).reshape(B, L, H, D)


def _multiscale_pool(p, pool_w, pool_scale):
    B, L, _ = p.shape
    pf = p.astype(jnp.float32).reshape(B, L, POOL_GROUPS, POOL_GROUP_DIM)
    csum = jnp.cumsum(pf, axis=1)
    t = (jnp.arange(L, dtype=jnp.int32) + 1).astype(jnp.float32)
    means = []
    for gi, win in enumerate(POOL_WINDOWS):
        c = csum[:, :, gi]
        lag = jnp.pad(c, ((0, 0), (win, 0), (0, 0)))[:, :L]
        cnt = jnp.minimum(t, float(win))[None, :, None]
        means.append((c - lag) / cnt)
    mixed = jnp.stack(means, axis=2) - pf
    y = jnp.einsum("blgc,gcd->blgd", mixed, pool_w.astype(jnp.float32)).reshape(B, L, POOL_WIDTH)
    return (y * pool_scale.astype(jnp.float32)).astype(p.dtype)


def _hybrid_mixer(h, w_in, conv_w, a_log, dt_bias, dn_norm_w, w_dn_branch,
                  pool_w, pool_scale, w_pool_branch, w_mix_out):
    B, L, _ = h.shape
    proj = h @ w_in
    qkv, z, a, b, p, gate_dn, gate_pool = jnp.split(proj, IN_SPLITS, axis=-1)

    qkv = jax.nn.silu(_causal_dwconv(qkv, conv_w)).astype(jnp.float32)
    q, k, v = jnp.split(qkv, 3, axis=-1)
    hs = (B, L, DN_HEADS, DN_HEAD_DIM)
    q = _l2norm(q.reshape(hs)) * (DN_HEAD_DIM ** -0.5)
    k = _l2norm(k.reshape(hs))
    v = v.reshape(hs)
    beta = jax.nn.sigmoid(b.astype(jnp.float32))
    g = -jnp.exp(a_log.astype(jnp.float32)) * jax.nn.softplus(
        a.astype(jnp.float32) + dt_bias.astype(jnp.float32))
    o = _gated_delta_rule(q, k, v, g, beta)
    o = o * lax.rsqrt(jnp.mean(jnp.square(o), axis=-1, keepdims=True) + RMS_EPS)
    o = o * dn_norm_w.astype(jnp.float32) * jax.nn.silu(z.astype(jnp.float32).reshape(hs))
    y_dn = o.reshape(B, L, DN_WIDTH).astype(h.dtype) @ w_dn_branch

    y_pool = _multiscale_pool(p, pool_w, pool_scale) @ w_pool_branch

    merged = jax.nn.sigmoid(gate_dn) * y_dn + jax.nn.sigmoid(gate_pool) * y_pool
    return merged @ w_mix_out


def _cross_attention(h, m, wq, wk, wv, wo):
    B, L, _ = h.shape
    q = (h @ wq).reshape(B, L, XA_HEADS, XA_HEAD_DIM)
    k = (m @ wk).reshape(B, N_MEM, XA_HEADS, XA_HEAD_DIM)
    v = (m @ wv).reshape(B, N_MEM, XA_HEADS, XA_HEAD_DIM)
    s = jnp.einsum("bqhd,bkhd->bhqk", q, k).astype(jnp.float32) * (XA_HEAD_DIM ** -0.5)
    pr = jax.nn.softmax(s, axis=-1).astype(h.dtype)
    o = jnp.einsum("bhqk,bkhd->bqhd", pr, v).reshape(B, L, D_MODEL)
    return o @ wo


def setup_inputs(seed: int = 0) -> dict:
    key = jax.random.key(seed)
    ks = iter(jax.random.split(key, 40))
    f32 = jnp.float32

    def nrm(shape, scale):
        return jax.random.normal(next(ks), shape, f32) * scale

    def gain(shape):
        return 1.0 + 0.02 * jax.random.normal(next(ks), shape, f32)

    def bias(shape):
        return 0.02 * jax.random.normal(next(ks), shape, f32)

    Dp = DEPTH
    d = D_MODEL
    x = jax.random.normal(next(ks), (BATCH, SEQ, d), f32)
    mem = jax.random.normal(next(ks), (BATCH, N_MEM, d), f32)

    ffn1_w_gate = nrm((Dp, d, D_FF), d ** -0.5)
    ffn1_w_up = nrm((Dp, d, D_FF), d ** -0.5)
    ffn1_w_down = nrm((Dp, D_FF, d), BETA_INIT * D_FF ** -0.5)
    ln1_g, ln1_b = gain((Dp, d)), bias((Dp, d))

    w_in = nrm((Dp, d, IN_COLS), d ** -0.5)
    conv_w = nrm((Dp, CONV_K, 3 * DN_WIDTH), CONV_K ** -0.5)
    a_log = jnp.log(jax.random.uniform(next(ks), (Dp, DN_HEADS), f32, 1.0, 16.0))
    dt = jnp.exp(jax.random.uniform(next(ks), (Dp, DN_HEADS), f32,
                                    float(np.log(1e-3)), float(np.log(1e-1))))
    dt_bias = dt + jnp.log(-jnp.expm1(-dt))
    dn_norm_w = gain((Dp, DN_HEAD_DIM))
    w_dn_branch = nrm((Dp, DN_WIDTH, d), DN_WIDTH ** -0.5)
    pool_w = nrm((Dp, POOL_GROUPS, POOL_GROUP_DIM, POOL_GROUP_DIM), POOL_GROUP_DIM ** -0.5)
    pool_scale = gain((Dp, POOL_WIDTH))
    w_pool_branch = nrm((Dp, POOL_WIDTH, d), POOL_WIDTH ** -0.5)
    w_mix_out = nrm((Dp, d, d), BETA_INIT * d ** -0.5)
    ln2_g, ln2_b = gain((Dp, d)), bias((Dp, d))

    mem_ln_g, mem_ln_b = gain((Dp, d)), bias((Dp, d))
    xa_wq = nrm((Dp, d, d), d ** -0.5)
    xa_wk = nrm((Dp, d, d), d ** -0.5)
    xa_wv = nrm((Dp, d, d), d ** -0.5)
    xa_wo = nrm((Dp, d, d), BETA_INIT * d ** -0.5)
    ln3_g, ln3_b = gain((Dp, d)), bias((Dp, d))

    ffn2_w_gate = nrm((Dp, d, D_FF), d ** -0.5)
    ffn2_w_up = nrm((Dp, d, D_FF), d ** -0.5)
    ffn2_w_down = nrm((Dp, D_FF, d), BETA_INIT * D_FF ** -0.5)
    ln4_g, ln4_b = gain((Dp, d)), bias((Dp, d))

    return {"x": x, "mem": mem,
            "ffn1_w_gate": ffn1_w_gate, "ffn1_w_up": ffn1_w_up, "ffn1_w_down": ffn1_w_down,
            "ln1_g": ln1_g, "ln1_b": ln1_b,
            "w_in": w_in, "conv_w": conv_w, "a_log": a_log, "dt_bias": dt_bias,
            "dn_norm_w": dn_norm_w, "w_dn_branch": w_dn_branch,
            "pool_w": pool_w, "pool_scale": pool_scale, "w_pool_branch": w_pool_branch,
            "w_mix_out": w_mix_out, "ln2_g": ln2_g, "ln2_b": ln2_b,
            "mem_ln_g": mem_ln_g, "mem_ln_b": mem_ln_b,
            "xa_wq": xa_wq, "xa_wk": xa_wk, "xa_wv": xa_wv, "xa_wo": xa_wo,
            "ln3_g": ln3_g, "ln3_b": ln3_b,
            "ffn2_w_gate": ffn2_w_gate, "ffn2_w_up": ffn2_w_up, "ffn2_w_down": ffn2_w_down,
            "ln4_g": ln4_g, "ln4_b": ln4_b}


def reference(x, mem, ffn1_w_gate, ffn1_w_up, ffn1_w_down, ln1_g, ln1_b,
              w_in, conv_w, a_log, dt_bias, dn_norm_w, w_dn_branch,
              pool_w, pool_scale, w_pool_branch, w_mix_out, ln2_g, ln2_b,
              mem_ln_g, mem_ln_b, xa_wq, xa_wk, xa_wv, xa_wo, ln3_g, ln3_b,
              ffn2_w_gate, ffn2_w_up, ffn2_w_down, ln4_g, ln4_b):
    for l in range(DEPTH):
        x = _layernorm(ALPHA * x + 0.5 * _swiglu(x, ffn1_w_gate[l], ffn1_w_up[l], ffn1_w_down[l]),
                       ln1_g[l], ln1_b[l])
        mix = _hybrid_mixer(x, w_in[l], conv_w[l], a_log[l], dt_bias[l], dn_norm_w[l],
                            w_dn_branch[l], pool_w[l], pool_scale[l], w_pool_branch[l], w_mix_out[l])
        x = _layernorm(ALPHA * x + mix, ln2_g[l], ln2_b[l])
        m = _layernorm(mem, mem_ln_g[l], mem_ln_b[l])
        xa = _cross_attention(x, m, xa_wq[l], xa_wk[l], xa_wv[l], xa_wo[l])
        x = _layernorm(ALPHA * x + xa, ln3_g[l], ln3_b[l])
        x = _layernorm(ALPHA * x + 0.5 * _swiglu(x, ffn2_w_gate[l], ffn2_w_up[l], ffn2_w_down[l]),
                       ln4_g[l], ln4_b[l])
    return x
```

```cpp
#include <hip/hip_runtime.h>
#include <hip/hip_cooperative_groups.h>
#include <cstdio>
namespace cg = cooperative_groups;
#ifndef PER_PHASE_LAUNCH
#define PER_PHASE_LAUNCH 0
#endif

#define LAS __attribute__((address_space(3)))
typedef unsigned short bf16_t;
typedef short bf16x8 __attribute__((ext_vector_type(8)));
typedef float f32x4 __attribute__((ext_vector_type(4)));
typedef float f32x2 __attribute__((ext_vector_type(2)));
typedef unsigned u32x4 __attribute__((ext_vector_type(4)));
typedef unsigned u32x2 __attribute__((ext_vector_type(2)));

constexpr int MTOK = 16384, DM = 1024, FF = 2816, NTHR = 512;
constexpr int LDS_BYTES = 147456;
constexpr float ALPHA = 1.189207115002721f;

constexpr size_t MiB = 1u << 20;
constexpr size_t WS_FFNGU = 0;
constexpr size_t WS_FFND  = 11 * MiB;
constexpr size_t WS_WINT  = 16 * MiB + MiB / 2;
constexpr size_t WS_CATW  = WS_WINT + 9 * MiB;
constexpr size_t WS_WMIXT = WS_CATW + 2 * MiB;
constexpr size_t WS_WQ    = WS_WMIXT + 2 * MiB;
constexpr size_t WS_WKVT  = WS_WQ + 2 * MiB;
constexpr size_t WS_WOT   = WS_WKVT + 4 * MiB;
constexpr size_t WS_MB    = WS_WOT + 2 * MiB;
constexpr size_t WS_KV    = WS_MB + 2 * MiB;
constexpr size_t WS_KQT   = WS_KV + 4 * MiB;
constexpr size_t WS_VWOT  = WS_KQT + 8 * MiB;
constexpr size_t WS_SMALL = WS_VWOT + 8 * MiB;
constexpr size_t WS_HALO  = WS_SMALL + 1 * MiB;
constexpr size_t WS_A     = WS_HALO + 2 * MiB + MiB / 2;
constexpr size_t WS_H     = WS_A + 32 * MiB;
constexpr size_t WS_G     = WS_H + 88 * MiB;
constexpr size_t WS_END   = WS_G + 64 * MiB;
constexpr size_t WS_QKVB = WS_H, WS_ZB = WS_H + 48 * MiB, WS_PP = WS_H + 64 * MiB, WS_ATT = WS_H + 80 * MiB;
constexpr size_t WS_O = WS_PP, WS_MERGED = WS_H, WS_PB = WS_H, WS_WBUF = WS_FFNGU;
constexpr size_t WS_GARR = WS_SMALL, WS_BETA = WS_SMALL + 256 * 1024, WS_GL = WS_SMALL + 512 * 1024;

struct KParams { const float* in[32]; float* out; unsigned char* ws; int lo, hi; };

__device__ __forceinline__ int opaque_tid() { int t = threadIdx.x; asm volatile("" : "+v"(t)); return t; }
typedef __bf16 bf16x2_t __attribute__((ext_vector_type(2)));
__device__ __forceinline__ unsigned cvt_pk_bf16(float lo, float hi) { const f32x2 v = {lo, hi}; return __builtin_bit_cast(unsigned, __builtin_convertvector(v, bf16x2_t)); }
__device__ __forceinline__ bf16_t f2bf(float f) { return (bf16_t)(cvt_pk_bf16(f, 0.f) & 0xffffu); }
__device__ __forceinline__ float bf_lo(unsigned w) { return __uint_as_float(w << 16); }
__device__ __forceinline__ float bf_hi(unsigned w) { return __uint_as_float(w & 0xffff0000u); }
__device__ __forceinline__ float bf2f(bf16_t b) { return __uint_as_float(((unsigned)b) << 16); }
__device__ __forceinline__ float sigmoidf_(float x) { return __builtin_amdgcn_rcpf(1.0f + __expf(-x)); }
__device__ __forceinline__ float siluf_(float x) { return x * __builtin_amdgcn_rcpf(1.0f + __expf(-x)); }
__device__ __forceinline__ float wave_sum(float v) { v += __shfl_xor(v, 32); v += __shfl_xor(v, 16); v += __shfl_xor(v, 8); v += __shfl_xor(v, 4); v += __shfl_xor(v, 2); v += __shfl_xor(v, 1); return v; }
__device__ __forceinline__ void unpack8(const u32x4 w, float (&f)[8]) { f[0] = bf_lo(w.x); f[1] = bf_hi(w.x); f[2] = bf_lo(w.y); f[3] = bf_hi(w.y); f[4] = bf_lo(w.z); f[5] = bf_hi(w.z); f[6] = bf_lo(w.w); f[7] = bf_hi(w.w); }
__device__ __forceinline__ u32x4 pack8(const float (&f)[8]) { u32x4 w; w.x = cvt_pk_bf16(f[0], f[1]); w.y = cvt_pk_bf16(f[2], f[3]); w.z = cvt_pk_bf16(f[4], f[5]); w.w = cvt_pk_bf16(f[6], f[7]); return w; }

namespace pg8 {
constexpr int BM = 256, BK = 64, HALF = 128, HTB = HALF * BK * 2, STAGE_BYTES = 8 * HTB, NXCD = 8, WGM = 8;
__device__ __forceinline__ int lds_byte(int r, int c) { const int st = (r >> 4) * 2 + (c >> 5), rr = r & 15, cc = c & 31, ob = rr * 64 + cc * 2; return st * 1024 + (ob ^ (((ob >> 9) & 1) << 5)); }
__device__ __forceinline__ void stage_rc(int b, int& R, int& C) { const int st = b / 1024, sb = b % 1024, swz = sb ^ (((sb >> 9) & 1) << 5); R = (st >> 1) * 16 + swz / 64; C = (st & 1) * 32 + (swz % 64) / 2; }
__device__ __forceinline__ int perm32(int rho) { const int n = rho >> 4, i = rho & 15; return 8 * (i >> 2) + 4 * n + (i & 3); }
struct Unit { int pm, pn; };
struct StaticOrder {
    int nM, nN, nwg, G, c;
    __device__ void init(int nM_, int nN_, int G_, int c_) { nM = nM_; nN = nN_; nwg = nM * nN; G = G_; c = c_; }
    __device__ bool next(int i, Unit& u) const {
        if (c < 0) return false;
        const long L = (long)i * G + c; if (L >= nwg) return false;
        int wgid = (int)L; { const int q = nwg / NXCD, r = nwg % NXCD, xcd = wgid % NXCD, off = wgid / NXCD; wgid = (xcd < r ? xcd * (q + 1) : r * (q + 1) + (xcd - r) * q) + off; }
        const int nig = WGM * nN, gid = wgid / nig, fm = gid * WGM, gsz = (nM - fm) < WGM ? (nM - fm) : WGM;
        u.pm = fm + ((wgid % nig) % gsz); u.pn = (wgid % nig) / gsz; return true;
    }
};
template <class Desc, class Epi, class Sched>
__device__ __forceinline__ void gemm_phase(LAS unsigned char* lds, const Desc& g, const Sched& S, const Epi& E) {
    const int tid = opaque_tid(), wid = __builtin_amdgcn_readfirstlane(tid >> 6), lane = tid & 63, wr = wid >> 2, wc = wid & 3, fr = lane & 15, fq = lane >> 4;
    const int K = g.K, nt = K / BK;
    unsigned voffA[2], voffB[2];
#pragma unroll
    for (int i = 0; i < 2; ++i) { int R, C; stage_rc(tid * 16 + i * 8192, R, C); const int Rb = Epi::PERM ? ((R & ~31) + perm32(R & 31)) : R;
        voffA[i] = (unsigned)(R * g.lda + C) * 2u; voffB[i] = (unsigned)(Rb * g.ldb + C) * 2u; }
    const size_t kstep = (size_t)(BK * 2);
    const size_t hstepA = (size_t)HALF * g.lda * 2, hstepB = (size_t)HALF * g.ldb * 2;
    const unsigned ldsw = (unsigned)wid * 1024u;
    const int aoff = lds_byte(wr * 64 + fr, fq * 8), boff = lds_byte(wc * 32 + fr, fq * 8);
#define PG8_SA(b, h) (((b) * 2 + (h)) * HTB)
#define PG8_SB(b, h) ((4 + (b) * 2 + (h)) * HTB)
#define PG8_STAGE(bufoff, gbase, voff) do { _Pragma("unroll") for (int _i = 0; _i < 2; ++_i) \
        __builtin_amdgcn_global_load_lds((const unsigned*)((const char*)(gbase) + (voff)[_i]), (LAS unsigned*)(lds + (bufoff) + ldsw + _i * 8192), 16, 0, 0); } while (0)
#define PG8_LDA(dst, b, h) do { _Pragma("unroll") for (int m = 0; m < 4; ++m) _Pragma("unroll") for (int k = 0; k < 2; ++k) dst[m][k] = *(const LAS bf16x8*)(lds + PG8_SA(b, h) + aoff + m * 2048 + k * 1024); } while (0)
#define PG8_LDB(dst, b, h) do { _Pragma("unroll") for (int n = 0; n < 2; ++n) _Pragma("unroll") for (int k = 0; k < 2; ++k) dst[n][k] = *(const LAS bf16x8*)(lds + PG8_SB(b, h) + boff + n * 2048 + k * 1024); } while (0)
#define PG8_MMA(ai, bj, At, Bt) do { __builtin_amdgcn_s_setprio(1); _Pragma("unroll") for (int m = 0; m < 4; ++m) _Pragma("unroll") for (int n = 0; n < 2; ++n) _Pragma("unroll") for (int k = 0; k < 2; ++k) \
        acc[ai][bj][m][n] = __builtin_amdgcn_mfma_f32_16x16x32_bf16(Bt[n][k], At[m][k], acc[ai][bj][m][n], 0, 0, 0); __builtin_amdgcn_s_setprio(0); } while (0)
#define PG8_WAIT_V(n) asm volatile("s_waitcnt vmcnt(" #n ")" ::: "memory")
#define PG8_WAIT_L(n) asm volatile("s_waitcnt lgkmcnt(" #n ")" ::: "memory")
#define PG8_BAR __builtin_amdgcn_s_barrier()
#define PG8_SCHED __builtin_amdgcn_sched_barrier(0)
    Unit cur, nxt; int ui = 0;
    if (!S.next(0, cur)) return;
    f32x4 acc[2][2][4][2];
#pragma unroll
    for (int a = 0; a < 2; ++a)
#pragma unroll
        for (int b = 0; b < 2; ++b)
#pragma unroll
            for (int m = 0; m < 4; ++m)
#pragma unroll
                for (int n = 0; n < 2; ++n) acc[a][b][m][n] = (f32x4){0.f, 0.f, 0.f, 0.f};
    bf16x8 At[4][2], B0[2][2], B1[2][2];
    const char* cA = g.abase(cur); const char* cB = g.bbase(cur);
    PG8_STAGE(PG8_SB(0, 0), cB, voffB); PG8_STAGE(PG8_SA(0, 0), cA, voffA); PG8_STAGE(PG8_SB(0, 1), cB + hstepB, voffB); PG8_STAGE(PG8_SA(0, 1), cA + hstepA, voffA);
    if (wr == 1) PG8_BAR;
    PG8_WAIT_V(4); PG8_BAR;
    PG8_STAGE(PG8_SB(1, 0), cB + kstep, voffB); PG8_STAGE(PG8_SA(1, 0), cA + kstep, voffA); PG8_STAGE(PG8_SB(1, 1), cB + hstepB + kstep, voffB);
    PG8_WAIT_V(6); PG8_BAR;
    for (;;) {
        const bool has_next = S.next(ui + 1, nxt);
        const char* nA = has_next ? g.abase(nxt) : cA; const char* nB = has_next ? g.bbase(nxt) : cB;
        for (int t = 0; t < nt; t += 2) {
            const bool last = (t == nt - 2);
            const char* a1 = cA + (size_t)(t + 1) * kstep;
            const char* a2 = last ? nA : cA + (size_t)(t + 2) * kstep; const char* b2 = last ? nB : cB + (size_t)(t + 2) * kstep;
            const char* a3 = a2 + kstep; const char* b3 = b2 + kstep;
            if constexpr (Epi::HAS_MID) { if (t == nt / 2) E.mid(acc, cur, wr, wc, fr, fq); }
            PG8_LDB(B0, 0, 0); PG8_SCHED; PG8_LDA(At, 0, 0); PG8_STAGE(PG8_SA(1, 1), a1 + hstepA, voffA);
            PG8_WAIT_L(8); PG8_BAR; PG8_WAIT_L(0); PG8_MMA(0, 0, At, B0); PG8_BAR; PG8_SCHED;
            PG8_LDB(B1, 0, 1); PG8_STAGE(PG8_SB(0, 0), b2, voffB);
            PG8_BAR; PG8_WAIT_L(0); PG8_MMA(0, 1, At, B1); PG8_BAR;
            PG8_LDA(At, 0, 1); PG8_STAGE(PG8_SA(0, 0), a2, voffA);
            PG8_BAR; PG8_WAIT_L(0); PG8_MMA(1, 0, At, B0); PG8_BAR; PG8_SCHED;
            PG8_STAGE(PG8_SB(0, 1), b2 + hstepB, voffB);
            PG8_WAIT_V(6); PG8_BAR; PG8_MMA(1, 1, At, B1); PG8_BAR;
            PG8_LDB(B0, 1, 0); PG8_SCHED; PG8_LDA(At, 1, 0); PG8_STAGE(PG8_SA(0, 1), a2 + hstepA, voffA);
            PG8_WAIT_L(8); PG8_BAR; PG8_WAIT_L(0); PG8_MMA(0, 0, At, B0); PG8_BAR; PG8_SCHED;
            PG8_LDB(B1, 1, 1); PG8_STAGE(PG8_SB(1, 0), b3, voffB);
            PG8_BAR; PG8_WAIT_L(0); PG8_MMA(0, 1, At, B1); PG8_BAR;
            PG8_LDA(At, 1, 1); PG8_STAGE(PG8_SA(1, 0), a3, voffA);
            PG8_BAR; PG8_WAIT_L(0); PG8_MMA(1, 0, At, B0); PG8_BAR; PG8_SCHED;
            PG8_STAGE(PG8_SB(1, 1), b3 + hstepB, voffB);
            PG8_WAIT_V(6); PG8_BAR; PG8_MMA(1, 1, At, B1); PG8_BAR;
        }
        if constexpr (!Epi::AFTER_DRAIN) { E(acc, cur, wr, wc, fr, fq); }
        if (!has_next) break;
#pragma unroll
        for (int a = 0; a < 2; ++a)
#pragma unroll
            for (int b = 0; b < 2; ++b)
#pragma unroll
                for (int m = 0; m < 4; ++m)
#pragma unroll
                    for (int n = 0; n < 2; ++n) acc[a][b][m][n] = (f32x4){0.f, 0.f, 0.f, 0.f};
        cur = nxt; cA = nA; cB = nB; ++ui;
    }
    PG8_WAIT_V(0);
    if (wr == 0) PG8_BAR;
    PG8_BAR;
    if constexpr (Epi::AFTER_DRAIN) { E.fused(acc, cur, wr, wc, fr, fq, lds, wid, lane); }
#undef PG8_SA
#undef PG8_SB
#undef PG8_STAGE
#undef PG8_LDA
#undef PG8_LDB
#undef PG8_MMA
#undef PG8_WAIT_V
#undef PG8_WAIT_L
#undef PG8_BAR
#undef PG8_SCHED
}
}
using pg8::Unit;
typedef f32x4 AccT[2][2][4][2];

struct DescPlain {
    const bf16_t* A; const bf16_t* Bt; int K, lda, ldb; int bshift; size_t bstride;
    __device__ __forceinline__ const char* abase(const Unit& u) const { return (const char*)(A + (size_t)u.pm * 256 * lda); }
    __device__ __forceinline__ const char* bbase(const Unit& u) const { return (const char*)(Bt + (size_t)u.pn * 256 * ldb + (size_t)(u.pm >> bshift) * bstride); }
};
struct DescKQ {
    const bf16_t* KV; const bf16_t* Wq; int K, lda, ldb;
    __device__ __forceinline__ const char* abase(const Unit& u) const { return (const char*)(KV + (size_t)(u.pm >> 2) * 256 * 2048 + (u.pm & 3) * 256); }
    __device__ __forceinline__ const char* bbase(const Unit& u) const { return (const char*)(Wq + (size_t)u.pn * 256 * 1024 + (u.pm & 3) * 256); }
};
struct DescVWo {
    const bf16_t* WoT; const bf16_t* KV; int K, lda, ldb;
    __device__ __forceinline__ const char* abase(const Unit& u) const { return (const char*)(WoT + (size_t)u.pm * 256 * 1024 + (u.pn & 3) * 256); }
    __device__ __forceinline__ const char* bbase(const Unit& u) const { return (const char*)(KV + (size_t)(u.pn >> 2) * 256 * 2048 + 1024 + (u.pn & 3) * 256); }
};

__device__ __forceinline__ void store_tile_bf16(const AccT& acc, bf16_t* tile00, int ldc, float scale, bool sig, int wr, int wc, int fr, int fq) {
    bf16_t* p0 = tile00 + (size_t)(wr * 64 + fr) * ldc + wc * 32 + 8 * fq;
#pragma unroll
    for (int ai = 0; ai < 2; ++ai)
#pragma unroll
        for (int m = 0; m < 4; ++m) { bf16_t* rowp = p0 + (size_t)(ai * 128 + m * 16) * ldc;
#pragma unroll
            for (int bj = 0; bj < 2; ++bj) { f32x4 v0 = acc[ai][bj][m][0] * scale, v1 = acc[ai][bj][m][1] * scale;
                if (sig) {
#pragma unroll
                    for (int j = 0; j < 4; ++j) { v0[j] = sigmoidf_(v0[j]); v1[j] = sigmoidf_(v1[j]); } }
                u32x4 w; w.x = cvt_pk_bf16(v0[0], v0[1]); w.y = cvt_pk_bf16(v0[2], v0[3]); w.z = cvt_pk_bf16(v1[0], v1[1]); w.w = cvt_pk_bf16(v1[2], v1[3]);
                *(u32x4*)(rowp + bj * 128) = w; }
            asm volatile("" ::: "memory"); }
}
struct EpiSwiglu {
    static constexpr bool PERM = false, AFTER_DRAIN = false, HAS_MID = false;
    bf16_t* H;
    __device__ __forceinline__ void operator()(const AccT& acc, const Unit& u, int wr, int wc, int fr, int fq) const {
        const int row0 = u.pm * 256 + wr * 64 + fr, col0 = u.pn * 128 + wc * 16 + 4 * fq;
#pragma unroll
        for (int ai = 0; ai < 2; ++ai)
#pragma unroll
            for (int m = 0; m < 4; ++m) { bf16_t* rowp = H + (size_t)(row0 + ai * 128 + m * 16) * FF + col0;
#pragma unroll
                for (int bj = 0; bj < 2; ++bj) { const f32x4 gt = acc[ai][bj][m][0], up = acc[ai][bj][m][1]; f32x4 h;
#pragma unroll
                    for (int j = 0; j < 4; ++j) h[j] = siluf_(gt[j]) * up[j];
                    u32x2 w; w.x = cvt_pk_bf16(h[0], h[1]); w.y = cvt_pk_bf16(h[2], h[3]); *(u32x2*)(rowp + bj * 64) = w; } }
    }
};
struct EpiResF32 {
    static constexpr bool PERM = false, AFTER_DRAIN = false, HAS_MID = false;
    const float* res; float* out; float scale;
    __device__ __forceinline__ void operator()(const AccT& acc, const Unit& u, int wr, int wc, int fr, int fq) const {
        const int row0 = u.pm * 256 + wr * 64 + fr, col0 = u.pn * 256 + wc * 32 + 4 * fq;
#pragma unroll
        for (int ai = 0; ai < 2; ++ai)
#pragma unroll
            for (int m = 0; m < 4; ++m) { const size_t off = (size_t)(row0 + ai * 128 + m * 16) * DM + col0;
                f32x4 r[2][2];
#pragma unroll
                for (int bj = 0; bj < 2; ++bj)
#pragma unroll
                    for (int n = 0; n < 2; ++n) r[bj][n] = *(const f32x4*)(res + off + bj * 128 + n * 16);
#pragma unroll
                for (int bj = 0; bj < 2; ++bj)
#pragma unroll
                    for (int n = 0; n < 2; ++n) *(f32x4*)(out + off + bj * 128 + n * 16) = r[bj][n] * ALPHA + acc[ai][bj][m][n] * scale;
                asm volatile("" ::: "memory"); }
    }
};
struct EpiWin {
    static constexpr bool PERM = true, AFTER_DRAIN = false, HAS_MID = false;
    unsigned char* ws;
    __device__ __forceinline__ void operator()(const AccT& acc, const Unit& u, int wr, int wc, int fr, int fq) const {
        const int pn = u.pn; const size_t r0 = (size_t)u.pm * 256;
        size_t boff; int ldc, ct;
        if (pn < 6) { boff = WS_QKVB; ldc = 1536; ct = pn; }
        else if (pn < 8) { boff = WS_ZB; ldc = 512; ct = pn - 6; }
        else if (pn < 10) { boff = WS_PP; ldc = 512; ct = pn - 8; }
        else if (pn < 14) { boff = WS_G; ldc = 1024; ct = pn - 10; }
        else { boff = WS_G + 32 * MiB; ldc = 1024; ct = pn - 14; }
        store_tile_bf16(acc, (bf16_t*)(ws + boff) + r0 * ldc + ct * 256, ldc, 1.f, pn >= 10, wr, wc, fr, fq);
        if (pn < 6 && fr >= 13) {
            bf16_t* halo = (bf16_t*)(ws + WS_HALO);
#pragma unroll
            for (int ai = 0; ai < 2; ++ai) { const int row = u.pm * 256 + ai * 128 + wr * 64 + 48 + fr;
                bf16_t* rowp = halo + (size_t)((row >> 6) * 3 + (row & 63) - 61) * 1536 + pn * 256 + wc * 32 + 8 * fq;
#pragma unroll
                for (int bj = 0; bj < 2; ++bj) { const f32x4 v0 = acc[ai][bj][3][0], v1 = acc[ai][bj][3][1];
                    u32x4 w; w.x = cvt_pk_bf16(v0[0], v0[1]); w.y = cvt_pk_bf16(v0[2], v0[3]); w.z = cvt_pk_bf16(v1[0], v1[1]); w.w = cvt_pk_bf16(v1[2], v1[3]);
                    *(u32x4*)(rowp + bj * 128) = w; } }
        }
    }
};
struct EpiKV {
    static constexpr bool PERM = true, AFTER_DRAIN = false, HAS_MID = false;
    bf16_t* KV;
    __device__ __forceinline__ void operator()(const AccT& acc, const Unit& u, int wr, int wc, int fr, int fq) const {
        store_tile_bf16(acc, KV + (size_t)u.pm * 256 * 2048 + u.pn * 256, 2048, 1.f, false, wr, wc, fr, fq); }
};
struct EpiKQ {
    static constexpr bool PERM = true, AFTER_DRAIN = false, HAS_MID = false;
    bf16_t* KQT;
    __device__ __forceinline__ void operator()(const AccT& acc, const Unit& u, int wr, int wc, int fr, int fq) const {
        store_tile_bf16(acc, KQT + (size_t)u.pm * 256 * 1024 + u.pn * 256, 1024, 0.0625f, false, wr, wc, fr, fq); }
};
struct EpiVWo {
    static constexpr bool PERM = true, AFTER_DRAIN = false, HAS_MID = false;
    bf16_t* VWOT;
    __device__ __forceinline__ void operator()(const AccT& acc, const Unit& u, int wr, int wc, int fr, int fq) const {
        store_tile_bf16(acc, VWOT + (size_t)(u.pn >> 2) * 1024 * 1024 + (size_t)u.pm * 256 * 1024 + (u.pn & 3) * 256, 1024, 1.f, false, wr, wc, fr, fq); }
};
struct EpiMerge {
    static constexpr bool PERM = true, AFTER_DRAIN = false, HAS_MID = true;
    const bf16_t* GDN; const bf16_t* GPOOL; bf16_t* MERGED;
    __device__ __forceinline__ void mid(AccT& acc, const Unit& u, int wr, int wc, int fr, int fq) const {
        unsigned rb = (unsigned)(u.pm * 256 + wr * 64 + fr); asm volatile("" : "+v"(rb));
        const size_t base = (size_t)rb * 1024 + u.pn * 256 + wc * 32 + 8 * fq;
#pragma unroll
        for (int ai = 0; ai < 2; ++ai)
#pragma unroll
            for (int m = 0; m < 4; ++m) {
#pragma unroll
                for (int bj = 0; bj < 2; ++bj) { const size_t off = base + (size_t)(ai * 128 + m * 16) * 1024 + bj * 128;
                    const u32x4 g1 = *(const u32x4*)(GDN + off), g2 = *(const u32x4*)(GPOOL + off); float a[8], b[8]; unpack8(g1, a); unpack8(g2, b);
#pragma unroll
                    for (int j = 0; j < 4; ++j) { acc[ai][bj][m][0][j] *= a[j] * __builtin_amdgcn_rcpf(fmaxf(b[j], 1e-30f)); acc[ai][bj][m][1][j] *= a[4 + j] * __builtin_amdgcn_rcpf(fmaxf(b[4 + j], 1e-30f)); }
                    asm volatile("" ::: "memory"); } }
    }
    __device__ __forceinline__ void operator()(const AccT& acc, const Unit& u, int wr, int wc, int fr, int fq) const {
        const size_t base = (size_t)(u.pm * 256 + wr * 64 + fr) * 1024 + u.pn * 256 + wc * 32 + 8 * fq;
#pragma unroll
        for (int ai = 0; ai < 2; ++ai)
#pragma unroll
            for (int m = 0; m < 4; ++m) {
#pragma unroll
                for (int bj = 0; bj < 2; ++bj) { const size_t off = base + (size_t)(ai * 128 + m * 16) * 1024 + bj * 128;
                    const u32x4 g2 = *(const u32x4*)(GPOOL + off); float b[8]; unpack8(g2, b);
                    const f32x4 v0 = acc[ai][bj][m][0], v1 = acc[ai][bj][m][1];
                    u32x4 w; w.x = cvt_pk_bf16(v0[0] * b[0], v0[1] * b[1]); w.y = cvt_pk_bf16(v0[2] * b[2], v0[3] * b[3]); w.z = cvt_pk_bf16(v1[0] * b[4], v1[1] * b[5]); w.w = cvt_pk_bf16(v1[2] * b[6], v1[3] * b[7]);
                    *(u32x4*)(MERGED + off) = w; }
                asm volatile("" ::: "memory"); }
    }
};
struct EpiSoftmax {
    static constexpr bool PERM = true, AFTER_DRAIN = true, HAS_MID = false;
    bf16_t* PB;
    __device__ __forceinline__ void fused(AccT& acc, const Unit& u, int wr, int wc, int fr, int fq, LAS unsigned char* lds, int wid, int lane) const {
        LAS f32x2* P = (LAS f32x2*)lds;
#pragma unroll
        for (int ai = 0; ai < 2; ++ai)
#pragma unroll
            for (int m = 0; m < 4; ++m) {
                float mx = -3.0e38f;
#pragma unroll
                for (int bj = 0; bj < 2; ++bj)
#pragma unroll
                    for (int n = 0; n < 2; ++n)
#pragma unroll
                        for (int j = 0; j < 4; ++j) mx = fmaxf(mx, acc[ai][bj][m][n][j]);
                mx = fmaxf(mx, __shfl_xor(mx, 16)); mx = fmaxf(mx, __shfl_xor(mx, 32));
                float s = 0.f;
#pragma unroll
                for (int bj = 0; bj < 2; ++bj)
#pragma unroll
                    for (int n = 0; n < 2; ++n)
#pragma unroll
                        for (int j = 0; j < 4; ++j) s += __expf(acc[ai][bj][m][n][j] - mx);
                s += __shfl_xor(s, 16); s += __shfl_xor(s, 32);
                if (fq == 0) P[(ai * 128 + wr * 64 + m * 16 + fr) * 4 + wc] = (f32x2){mx, s};
            }
        __syncthreads();
#pragma unroll
        for (int ai = 0; ai < 2; ++ai)
#pragma unroll
            for (int m = 0; m < 4; ++m) { const int r = ai * 128 + wr * 64 + m * 16 + fr;
                const f32x2 p0 = P[r * 4 + 0], p1 = P[r * 4 + 1], p2 = P[r * 4 + 2], p3 = P[r * 4 + 3];
                const float M = fmaxf(fmaxf(p0.x, p1.x), fmaxf(p2.x, p3.x));
                const float S = p0.y * __expf(p0.x - M) + p1.y * __expf(p1.x - M) + p2.y * __expf(p2.x - M) + p3.y * __expf(p3.x - M);
                const float inv = 1.0f / S;
                bf16_t* rowp = PB + (size_t)(u.pm * 256 + r) * 1024 + u.pn * 256 + wc * 32 + 8 * fq;
#pragma unroll
                for (int bj = 0; bj < 2; ++bj) { float v[8];
#pragma unroll
                    for (int j = 0; j < 4; ++j) { v[j] = __expf(acc[ai][bj][m][0][j] - M) * inv; v[4 + j] = __expf(acc[ai][bj][m][1][j] - M) * inv; }
                    *(u32x4*)(rowp + bj * 128) = pack8(v); } }
    }
};

template <int MODE>
__device__ __forceinline__ void transpose_job(LAS float* tile, int K, int N, int src_ld, bf16_t* out, int out_ld, const float* s0, const float* s1, int rot) {
    const int tid = opaque_tid(), tk = K / 64, nt = tk * (N / 64);
    for (int t = (int)((blockIdx.x + rot) % gridDim.x); t < nt; t += gridDim.x) {
        const int k0 = (t % tk) * 64, n0 = (t / tk) * 64;
        { const int nl = tid & 63, kl = tid >> 6, n = n0 + nl; const float* cp;
          if (MODE == 0) cp = s0 + n;
          else if (MODE == 1) { const int w = n & 31, G = n >> 5; cp = ((w < 16) ? s0 : s1) + G * 16 + (w & 15); }
          else if (MODE == 2) cp = s0 + (n < 2048 ? n : n + 8);
          else cp = n < 1024 ? s0 + n : s1 + (n - 1024);
#pragma unroll
          for (int kk = 0; kk < 8; ++kk) { const int k = kk * 8 + kl; tile[k * 65 + nl] = cp[(size_t)(k0 + k) * src_ld]; } }
        __syncthreads();
        { const int nl = tid >> 3, ks = tid & 7; float v[8];
#pragma unroll
          for (int j = 0; j < 8; ++j) v[j] = tile[(ks * 8 + j) * 65 + nl];
          *(u32x4*)(out + (size_t)(n0 + nl) * out_ld + k0 + ks * 8) = pack8(v); }
        __syncthreads();
    }
}
__device__ __forceinline__ void convert_ffn_weights(LAS float* tile, const float* wg, const float* wu, const float* wd, unsigned char* ws) {
    transpose_job<1>(tile, 1024, 5632, FF, (bf16_t*)(ws + WS_FFNGU), 1024, wg, wu, 0);
    transpose_job<0>(tile, FF, 1024, 1024, (bf16_t*)(ws + WS_FFND), FF, wd, nullptr, 128);
}
__device__ __forceinline__ void ln_row(const float* src, const float* g, const float* b, int lane, f32x4 (&y)[4]) {
    f32x4 v[4];
#pragma unroll
    for (int j = 0; j < 4; ++j) v[j] = *(const f32x4*)(src + j * 256 + lane * 4);
    float s = 0.f;
#pragma unroll
    for (int j = 0; j < 4; ++j) s += (v[j][0] + v[j][1]) + (v[j][2] + v[j][3]);
    const float mean = wave_sum(s) * (1.0f / 1024.0f);
    float q = 0.f;
#pragma unroll
    for (int j = 0; j < 4; ++j) { const f32x4 d = v[j] - mean; q += (d[0] * d[0] + d[1] * d[1]) + (d[2] * d[2] + d[3] * d[3]); }
    const float rstd = 1.0f / sqrtf(wave_sum(q) * (1.0f / 1024.0f) + 1e-5f);
#pragma unroll
    for (int j = 0; j < 4; ++j) { const f32x4 gg = *(const f32x4*)(g + j * 256 + lane * 4), bb = *(const f32x4*)(b + j * 256 + lane * 4); y[j] = (v[j] - mean) * rstd * gg + bb; }
}
__device__ __forceinline__ void store_row_bf16(bf16_t* dst, int lane, const f32x4 (&y)[4]) {
#pragma unroll
    for (int j = 0; j < 4; ++j) { u32x2 w; w.x = cvt_pk_bf16(y[j][0], y[j][1]); w.y = cvt_pk_bf16(y[j][2], y[j][3]); *(u32x2*)(dst + j * 256 + lane * 4) = w; }
}
__device__ __forceinline__ void ln_phase(float* xio, bf16_t* xb, const float* g, const float* b) {
    const int tid = opaque_tid(), lane = tid & 63, wave = tid >> 6;
    for (int row = blockIdx.x * 8 + wave; row < MTOK; row += gridDim.x * 8) {
        f32x4 y[4]; ln_row(xio + (size_t)row * DM, g, b, lane, y);
#pragma unroll
        for (int j = 0; j < 4; ++j) *(f32x4*)(xio + (size_t)row * DM + j * 256 + lane * 4) = y[j];
        if (xb) store_row_bf16(xb + (size_t)row * DM, lane, y);
    }
}

__device__ __forceinline__ void dn_prep_unit(const KParams& P, LAS unsigned char* lds, int unit) {
    const int tid = opaque_tid(), lane = tid & 63, wave = tid >> 6;
    const int h = unit & 3, gchunk = unit >> 2, chunk = gchunk & 63; const size_t row0 = (size_t)gchunk * 64;
    bf16_t* qkvb = (bf16_t*)(P.ws + WS_QKVB); const bf16_t* halo = (const bf16_t*)(P.ws + WS_HALO);
    const float* garr = (const float*)(P.ws + WS_GARR); const float* betaarr = (const float*)(P.ws + WS_BETA);
    LAS unsigned char* KB16 = lds; LAS unsigned char* QB16 = lds + 17408; LAS unsigned char* KDT = lds + 34816;
    LAS float* RHS = (LAS float*)(lds + 53248); LAS float* AM = (LAS float*)(lds + 118784);
    LAS float* GC = (LAS float*)(lds + 135168); LAS float* BT = GC + 64;
    if (tid < 64) { float v = garr[(row0 + tid) * 4 + h];
#pragma unroll
        for (int off = 1; off < 64; off <<= 1) { const float t = __shfl_up(v, off); if (lane >= off) v += t; }
        GC[tid] = v; BT[tid] = betaarr[(row0 + tid) * 4 + h]; }
    __syncthreads();
    const int r = tid >> 3, seg = tid & 7, ch0 = seg * 16;
    const float gc_r = GC[r], beta_r = BT[r], gl = GC[63], egc_r = __expf(gc_r), ekd_r = __expf(gl - gc_r);
    float qn[16];
#pragma unroll
    for (int part = 0; part < 3; ++part) {
        const int col0 = part * 512 + h * 128 + ch0;
        float y[16];
#pragma unroll
        for (int c = 0; c < 16; ++c) y[c] = 0.f;
#pragma unroll
        for (int j = 0; j < 4; ++j) {
            const int tt = r - 3 + j; u32x4 w0 = (u32x4){0u, 0u, 0u, 0u}, w1 = w0;
            if (tt >= 0) { const bf16_t* p = qkvb + (row0 + tt) * 1536 + col0; w0 = *(const u32x4*)p; w1 = *(const u32x4*)(p + 8); }
            else if (chunk > 0) { const bf16_t* p = halo + (size_t)((gchunk - 1) * 3 + tt + 3) * 1536 + col0; w0 = *(const u32x4*)p; w1 = *(const u32x4*)(p + 8); }
            float x[16]; { float a[8], b[8]; unpack8(w0, a); unpack8(w1, b);
#pragma unroll
                for (int c = 0; c < 8; ++c) { x[c] = a[c]; x[8 + c] = b[c]; } }
            const float* cw = P.in[8] + j * 1536 + col0;
#pragma unroll
            for (int c4 = 0; c4 < 4; ++c4) { const f32x4 wv = *(const f32x4*)(cw + c4 * 4);
#pragma unroll
                for (int e = 0; e < 4; ++e) y[c4 * 4 + e] += wv[e] * x[c4 * 4 + e]; }
        }
        float ss = 0.f;
#pragma unroll
        for (int c = 0; c < 16; ++c) { y[c] = siluf_(y[c]); ss += y[c] * y[c]; }
        ss += __shfl_xor(ss, 1); ss += __shfl_xor(ss, 2); ss += __shfl_xor(ss, 4);
        if (part == 0) {
            const float sc = (1.0f / sqrtf(ss + 1e-6f)) * 0.08838834764831845f;
            float v[8];
#pragma unroll
            for (int c = 0; c < 16; ++c) qn[c] = y[c] * sc;
#pragma unroll
            for (int c = 0; c < 8; ++c) v[c] = qn[c];
            *(LAS u32x4*)(QB16 + r * 272 + ch0 * 2) = pack8(v);
#pragma unroll
            for (int c = 0; c < 8; ++c) v[c] = qn[8 + c];
            *(LAS u32x4*)(QB16 + r * 272 + ch0 * 2 + 16) = pack8(v);
        } else if (part == 1) {
            const float sc = 1.0f / sqrtf(ss + 1e-6f);
            float v[8];
#pragma unroll
            for (int c = 0; c < 16; ++c) y[c] *= sc;
#pragma unroll
            for (int c = 0; c < 8; ++c) v[c] = y[c];
            *(LAS u32x4*)(KB16 + r * 272 + ch0 * 2) = pack8(v);
#pragma unroll
            for (int c = 0; c < 8; ++c) v[c] = y[8 + c];
            *(LAS u32x4*)(KB16 + r * 272 + ch0 * 2 + 16) = pack8(v);
            const float bw = beta_r * egc_r;
#pragma unroll
            for (int c4 = 0; c4 < 4; ++c4) *(LAS f32x4*)(RHS + r * 256 + 128 + ch0 + c4 * 4) = (f32x4){y[c4 * 4] * bw, y[c4 * 4 + 1] * bw, y[c4 * 4 + 2] * bw, y[c4 * 4 + 3] * bw};
#pragma unroll
            for (int c = 0; c < 16; ++c) *(LAS bf16_t*)(KDT + (ch0 + c) * 144 + r * 2) = f2bf(y[c] * ekd_r);
        } else {
#pragma unroll
            for (int c4 = 0; c4 < 4; ++c4) *(LAS f32x4*)(RHS + r * 256 + ch0 + c4 * 4) = (f32x4){y[c4 * 4] * beta_r, y[c4 * 4 + 1] * beta_r, y[c4 * 4 + 2] * beta_r, y[c4 * 4 + 3] * beta_r};
        }
    }
    __syncthreads();
    {
        float v[8]; bf16_t* p = qkvb + (row0 + r) * 1536 + h * 128 + ch0;
#pragma unroll
        for (int c = 0; c < 8; ++c) v[c] = qn[c] * egc_r;
        *(u32x4*)p = pack8(v);
#pragma unroll
        for (int c = 0; c < 8; ++c) v[c] = qn[8 + c] * egc_r;
        *(u32x4*)(p + 8) = pack8(v);
    }
#pragma unroll
    for (int i = 0; i < 2; ++i) {
        const int idx = tid + i * 512, d = idx >> 3, pc = idx & 7;
        *(u32x4*)(qkvb + (row0 + (d >> 1)) * 1536 + 512 + h * 128 + (d & 1) * 64 + pc * 8) = *(const LAS u32x4*)(KDT + d * 144 + pc * 16);
    }
    {
        const int fr = lane & 15, fq = lane >> 4; const bool isA = wave < 4; const int ti = wave & 3;
        LAS unsigned char* X = isA ? KB16 : QB16;
        bf16_t* attb = (bf16_t*)(P.ws + WS_ATT) + (size_t)unit * 4096;
#pragma unroll
        for (int tj = 0; tj < 4; ++tj) {
            f32x4 acc = (f32x4){0.f, 0.f, 0.f, 0.f};
#pragma unroll
            for (int kk = 0; kk < 4; ++kk) {
                const bf16x8 a = *(const LAS bf16x8*)(X + (ti * 16 + fr) * 272 + (kk * 32 + fq * 8) * 2);
                const bf16x8 b = *(const LAS bf16x8*)(KB16 + (tj * 16 + fr) * 272 + (kk * 32 + fq * 8) * 2);
                acc = __builtin_amdgcn_mfma_f32_16x16x32_bf16(a, b, acc, 0, 0, 0);
            }
            const int jj = tj * 16 + fr; const float gcj = GC[jj];
#pragma unroll
            for (int j = 0; j < 4; ++j) { const int i = ti * 16 + fq * 4 + j; const float gci = GC[i];
                if (isA) AM[i * 64 + jj] = (i > jj) ? BT[i] * acc[j] * __expf(gci - gcj) : 0.f;
                else attb[i * 64 + jj] = f2bf((i >= jj) ? acc[j] * __expf(gci - gcj) : 0.f); }
        }
    }
    __syncthreads();
    if (tid < 256) {
        float sol[64]; int zv = 0; asm volatile("" : "+v"(zv));
        const LAS float* AMv = AM + zv;
#pragma unroll
        for (int i = 0; i < 64; ++i) {
            float s = RHS[i * 256 + tid];
#pragma unroll
            for (int j4 = 0; j4 < (i + 3) / 4; ++j4) { const f32x4 a = *(const LAS f32x4*)(AMv + i * 64 + j4 * 4);
#pragma unroll
                for (int e = 0; e < 4; ++e) if (j4 * 4 + e < i) s -= a[e] * sol[j4 * 4 + e]; }
            sol[i] = s;
        }
        if (tid < 128) {
#pragma unroll
            for (int i = 0; i < 64; ++i) qkvb[(row0 + i) * 1536 + 1024 + h * 128 + tid] = f2bf(sol[i]);
        } else { bf16_t* wb = (bf16_t*)(P.ws + WS_WBUF);
#pragma unroll
            for (int i = 0; i < 64; ++i) wb[(row0 + i) * 512 + h * 128 + (tid - 128)] = f2bf(sol[i]);
        }
    }
    if (tid == 0) ((float*)(P.ws + WS_GL))[unit * 32] = gl;
    __syncthreads();
}

__device__ __forceinline__ void dn_scan(const KParams& P, LAS unsigned char* lds) {
    if (blockIdx.x >= 128) return;
    const int tid = opaque_tid(), lane = tid & 63, wave = tid >> 6, fr = lane & 15, fq = lane >> 4;
    const int bh = blockIdx.x >> 3, es = blockIdx.x & 7, b = bh >> 2, h = bh & 3, e0 = es * 16;
    const bf16_t* qkvb = (const bf16_t*)(P.ws + WS_QKVB); const bf16_t* wbuf = (const bf16_t*)(P.ws + WS_WBUF);
    const bf16_t* attb = (const bf16_t*)(P.ws + WS_ATT); const float* glarr = (const float*)(P.ws + WS_GL);
    bf16_t* obuf = (bf16_t*)(P.ws + WS_O);
    constexpr int OFF_W = 0, OFF_QD = 17408, OFF_KDT = 34816, OFF_ATT = 53248, OFF_U = 62464, BUFSZ = 64512;
    LAS unsigned char* ST = lds + 2 * BUFSZ; LAS unsigned char* VNT = ST + 4352;
    for (int i = tid; i < 4352 / 4; i += NTHR) ((LAS unsigned*)ST)[i] = 0u;
    u32x4 rW[2], rQ[2], rK[2], rA, rU;
    const int wr_ = tid >> 4, wc_ = tid & 15;
    const int kd_ = tid >> 3, kp_ = tid & 7;
    const int ar_ = tid >> 3, ap_ = tid & 7;
    const int ur_ = tid >> 1, up_ = tid & 1;
#define SCAN_LOAD(n) do { const int gch = b * 64 + (n); const size_t r0 = (size_t)gch * 64; const int un = gch * 4 + h; \
        _Pragma("unroll") for (int i = 0; i < 2; ++i) { const int rr = wr_ + i * 32; \
            rW[i] = *(const u32x4*)(wbuf + (r0 + rr) * 512 + h * 128 + wc_ * 8); \
            rQ[i] = *(const u32x4*)(qkvb + (r0 + rr) * 1536 + h * 128 + wc_ * 8); \
            const int d = kd_ + i * 64; rK[i] = *(const u32x4*)(qkvb + (r0 + (d >> 1)) * 1536 + 512 + h * 128 + (d & 1) * 64 + kp_ * 8); } \
        rA = *(const u32x4*)(attb + (size_t)un * 4096 + ar_ * 64 + ap_ * 8); \
        if (tid < 128) rU = *(const u32x4*)(qkvb + (r0 + ur_) * 1536 + 1024 + h * 128 + e0 + up_ * 8); } while (0)
#define SCAN_STORE(buf) do { LAS unsigned char* B_ = lds + (buf) * BUFSZ; \
        _Pragma("unroll") for (int i = 0; i < 2; ++i) { const int rr = wr_ + i * 32; \
            *(LAS u32x4*)(B_ + OFF_W + rr * 272 + wc_ * 16) = rW[i]; *(LAS u32x4*)(B_ + OFF_QD + rr * 272 + wc_ * 16) = rQ[i]; \
            *(LAS u32x4*)(B_ + OFF_KDT + (kd_ + i * 64) * 144 + kp_ * 16) = rK[i]; } \
        *(LAS u32x4*)(B_ + OFF_ATT + ar_ * 144 + ap_ * 16) = rA; \
        if (tid < 128) *(LAS u32x4*)(B_ + OFF_U + ur_ * 32 + up_ * 16) = rU; } while (0)
    SCAN_LOAD(0); SCAN_STORE(0);
    __syncthreads();
    f32x4 sacc = (f32x4){0.f, 0.f, 0.f, 0.f};
    for (int n = 0; n < 64; ++n) {
        LAS unsigned char* B_ = lds + (n & 1) * BUFSZ;
        if (n + 1 < 64) SCAN_LOAD(n + 1);
        const float eg = __expf(glarr[((b * 64 + n) * 4 + h) * 32]);
        const int ct = wave & 3;
        f32x4 acc = (f32x4){0.f, 0.f, 0.f, 0.f};
        { LAS unsigned char* X = B_ + (wave < 4 ? OFF_W : OFF_QD);
#pragma unroll
          for (int kk = 0; kk < 4; ++kk) {
              const bf16x8 a = *(const LAS bf16x8*)(X + (ct * 16 + fr) * 272 + (kk * 32 + fq * 8) * 2);
              const bf16x8 s = *(const LAS bf16x8*)(ST + fr * 272 + (kk * 32 + fq * 8) * 2);
              acc = __builtin_amdgcn_mfma_f32_16x16x32_bf16(a, s, acc, 0, 0, 0); } }
        if (wave < 4) {
            float vn[4];
#pragma unroll
            for (int j = 0; j < 4; ++j) vn[j] = bf2f(*(const LAS bf16_t*)(B_ + OFF_U + (ct * 16 + fq * 4 + j) * 32 + fr * 2)) - acc[j];
            u32x2 w; w.x = cvt_pk_bf16(vn[0], vn[1]); w.y = cvt_pk_bf16(vn[2], vn[3]);
            *(LAS u32x2*)(VNT + fr * 144 + (ct * 16 + fq * 4) * 2) = w;
        }
        __syncthreads();
        if (wave >= 4) {
#pragma unroll
            for (int kk = 0; kk < 2; ++kk) {
                const bf16x8 a = *(const LAS bf16x8*)(B_ + OFF_ATT + (ct * 16 + fr) * 144 + (kk * 32 + fq * 8) * 2);
                const bf16x8 v = *(const LAS bf16x8*)(VNT + fr * 144 + (kk * 32 + fq * 8) * 2);
                acc = __builtin_amdgcn_mfma_f32_16x16x32_bf16(a, v, acc, 0, 0, 0); }
#pragma unroll
            for (int j = 0; j < 4; ++j) obuf[((size_t)(bh * 8 + es) * 4096 + n * 64 + ct * 16 + fq * 4 + j) * 16 + fr] = f2bf(acc[j]);
        }
        sacc *= eg;
#pragma unroll
        for (int kk = 0; kk < 2; ++kk) {
            const bf16x8 a = *(const LAS bf16x8*)(B_ + OFF_KDT + (wave * 16 + fr) * 144 + (kk * 32 + fq * 8) * 2);
            const bf16x8 v = *(const LAS bf16x8*)(VNT + fr * 144 + (kk * 32 + fq * 8) * 2);
            sacc = __builtin_amdgcn_mfma_f32_16x16x32_bf16(a, v, sacc, 0, 0, 0); }
        { u32x2 w; w.x = cvt_pk_bf16(sacc[0], sacc[1]); w.y = cvt_pk_bf16(sacc[2], sacc[3]);
          *(LAS u32x2*)(ST + fr * 272 + (wave * 16 + fq * 4) * 2) = w; }
        if (n + 1 < 64) SCAN_STORE((n + 1) & 1);
        __syncthreads();
    }
#undef SCAN_LOAD
#undef SCAN_STORE
}

#define GRID_SYNC() do { __builtin_amdgcn_fence(__ATOMIC_RELEASE, "agent"); __syncthreads(); grid.sync(); __builtin_amdgcn_fence(__ATOMIC_ACQUIRE, "agent"); asm volatile("s_waitcnt vmcnt(0)" ::: "memory"); __syncthreads(); } while (0)
__global__ void __launch_bounds__(NTHR) fwd_megakernel(KParams P) {
    extern __shared__ __attribute__((aligned(16))) unsigned char lds_raw[];
    LAS unsigned char* lds = (LAS unsigned char*)lds_raw;
    cg::grid_group grid = cg::this_grid();
    const int G = gridDim.x, bid = blockIdx.x;
    unsigned char* ws = P.ws;
    const float* x_in = P.in[0];
    float* xio = P.out;

    if (P.lo <= 0 && 0 <= P.hi) {
    {
        const int tid = opaque_tid(), lane = tid & 63, wave = tid >> 6;
        LAS float* tile = (LAS float*)lds;
        convert_ffn_weights(tile, P.in[2], P.in[3], P.in[4], ws);
        { const float* w = P.in[7];
          transpose_job<2>(tile, 1024, 4608, 4616, (bf16_t*)(ws + WS_WINT), 1024, w, nullptr, 64); }
        { const float* w = P.in[12]; transpose_job<0>(tile, 512, 1024, 1024, (bf16_t*)(ws + WS_CATW), 1024, w, nullptr, 32); }
        { const float* w = P.in[16]; transpose_job<0>(tile, 1024, 1024, 1024, (bf16_t*)(ws + WS_WMIXT), 1024, w, nullptr, 160); }
        { const float* wk = P.in[22]; const float* wv = P.in[23];
          transpose_job<3>(tile, 1024, 2048, 1024, (bf16_t*)(ws + WS_WKVT), 1024, wk, wv, 96); }
        { const float* w = P.in[24]; transpose_job<0>(tile, 1024, 1024, 1024, (bf16_t*)(ws + WS_WOT), 1024, w, nullptr, 224); }
        {
            const float* w = P.in[21]; bf16_t* o = (bf16_t*)(ws + WS_WQ);
            for (int i = bid * NTHR + tid; i < 1024 * 1024 / 8; i += G * NTHR) { const f32x4 a = *(const f32x4*)(w + (size_t)i * 8), b = *(const f32x4*)(w + (size_t)i * 8 + 4);
                u32x4 q; q.x = cvt_pk_bf16(a[0], a[1]); q.y = cvt_pk_bf16(a[2], a[3]); q.z = cvt_pk_bf16(b[0], b[1]); q.w = cvt_pk_bf16(b[2], b[3]); *(u32x4*)(o + (size_t)i * 8) = q; }
        }
        {
            const float* pw = P.in[13]; const float* sc = P.in[14]; const float* wpb = P.in[15]; bf16_t* o = (bf16_t*)(ws + WS_CATW);
            for (int idx = bid * NTHR + tid; idx < 65536; idx += G * NTHR) {
                const int n = (idx >> 3) & 1023, oct = (idx >> 13) * 8 + (idx & 7), gg = oct >> 4, c0 = (oct & 15) * 8;
                float a[8];
#pragma unroll
                for (int i = 0; i < 8; ++i) a[i] = 0.f;
                for (int d = 0; d < 128; ++d) { const float wv = wpb[(size_t)(gg * 128 + d) * 1024 + n] * sc[gg * 128 + d];
#pragma unroll
                    for (int i = 0; i < 8; ++i) a[i] += pw[(gg * 128 + c0 + i) * 128 + d] * wv; }
                *(u32x4*)(o + (size_t)n * 1024 + 512 + gg * 128 + c0) = pack8(a);
            }
        }
        {
            bf16_t* xb = (bf16_t*)(ws + WS_A);
            for (size_t i = (size_t)bid * NTHR + tid; i < (size_t)MTOK * DM / 8; i += (size_t)G * NTHR) { const f32x4 a = *(const f32x4*)(x_in + i * 8), b = *(const f32x4*)(x_in + i * 8 + 4);
                u32x4 q; q.x = cvt_pk_bf16(a[0], a[1]); q.y = cvt_pk_bf16(a[2], a[3]); q.z = cvt_pk_bf16(b[0], b[1]); q.w = cvt_pk_bf16(b[2], b[3]); *(u32x4*)(xb + i * 8) = q; }
        }
        for (int row = bid * 8 + wave; row < 1024; row += G * 8) { f32x4 y[4]; ln_row(P.in[1] + (size_t)row * DM, P.in[19], P.in[20], lane, y); store_row_bf16((bf16_t*)(ws + WS_MB) + (size_t)row * DM, lane, y); }
    }
    }
    if (P.lo <= 0 && 0 < P.hi) GRID_SYNC();

    if (P.lo <= 1 && 1 <= P.hi) {
    {
        DescPlain g{(const bf16_t*)(ws + WS_A), (const bf16_t*)(ws + WS_FFNGU), 1024, 1024, 1024, 30, 0};
        pg8::StaticOrder S; S.init(64, 22, G, bid); EpiSwiglu E{(bf16_t*)(ws + WS_H)};
        pg8::gemm_phase(lds, g, S, E);
        DescPlain g2{(const bf16_t*)(ws + WS_MB), (const bf16_t*)(ws + WS_WKVT), 1024, 1024, 1024, 30, 0};
        pg8::StaticOrder S2; S2.init(4, 8, G, G - 1 - bid); EpiKV E2{(bf16_t*)(ws + WS_KV)};
        pg8::gemm_phase(lds, g2, S2, E2);
    }
    }
    if (P.lo <= 1 && 1 < P.hi) GRID_SYNC();

    if (P.lo <= 2 && 2 <= P.hi) {
    {
        DescPlain g{(const bf16_t*)(ws + WS_H), (const bf16_t*)(ws + WS_FFND), FF, FF, FF, 30, 0};
        pg8::StaticOrder S; S.init(64, 4, G, bid); EpiResF32 E{x_in, xio, 0.5f};
        pg8::gemm_phase(lds, g, S, E);
    }
    }
    if (P.lo <= 2 && 2 < P.hi) GRID_SYNC();

    if (P.lo <= 3 && 3 <= P.hi) {
    {
        const int tid = opaque_tid(), lane = tid & 63, wave = tid >> 6;
        LAS float* wab = (LAS float*)lds;
        for (int i = tid; i < 8192; i += NTHR) wab[i] = P.in[7][(size_t)(i & 1023) * 4616 + 2048 + (i >> 10)];
        __syncthreads();
        bf16_t* xb = (bf16_t*)(ws + WS_A); float* garr = (float*)(ws + WS_GARR); float* betaarr = (float*)(ws + WS_BETA);
        for (int row = bid * 8 + wave; row < MTOK; row += G * 8) {
            f32x4 y[4]; ln_row(xio + (size_t)row * DM, P.in[5], P.in[6], lane, y);
#pragma unroll
            for (int j = 0; j < 4; ++j) *(f32x4*)(xio + (size_t)row * DM + j * 256 + lane * 4) = y[j];
            store_row_bf16(xb + (size_t)row * DM, lane, y);
            float s[8];
#pragma unroll
            for (int c = 0; c < 8; ++c) { float a = 0.f;
#pragma unroll
                for (int j = 0; j < 4; ++j) { const f32x4 wv = *(const LAS f32x4*)(wab + c * 1024 + j * 256 + lane * 4); a += (y[j][0] * wv[0] + y[j][1] * wv[1]) + (y[j][2] * wv[2] + y[j][3] * wv[3]); }
                s[c] = wave_sum(a); }
            if (lane < 4) {
                const float av = lane == 0 ? s[0] : lane == 1 ? s[1] : lane == 2 ? s[2] : s[3];
                const float bv = lane == 0 ? s[4] : lane == 1 ? s[5] : lane == 2 ? s[6] : s[7];
                const float xx = av + P.in[10][lane];
                const float sp = fmaxf(xx, 0.f) + log1pf(__expf(-fabsf(xx)));
                garr[(size_t)row * 4 + lane] = -__expf(P.in[9][lane]) * sp;
                betaarr[(size_t)row * 4 + lane] = 1.0f / (1.0f + __expf(-bv));
            }
        }
    }
    }
    if (P.lo <= 3 && 3 < P.hi) GRID_SYNC();

    if (P.lo <= 4 && 4 <= P.hi) {
    {
        DescPlain g{(const bf16_t*)(ws + WS_A), (const bf16_t*)(ws + WS_WINT), 1024, 1024, 1024, 30, 0};
        pg8::StaticOrder S; S.init(64, 18, G, bid); EpiWin E{ws};
        pg8::gemm_phase(lds, g, S, E);
        DescKQ g2{(const bf16_t*)(ws + WS_KV), (const bf16_t*)(ws + WS_WQ), 256, 2048, 1024};
        pg8::StaticOrder S2; S2.init(16, 4, G, G - 1 - bid); EpiKQ E2{(bf16_t*)(ws + WS_KQT)};
        pg8::gemm_phase(lds, g2, S2, E2);
        DescVWo g3{(const bf16_t*)(ws + WS_WOT), (const bf16_t*)(ws + WS_KV), 256, 1024, 2048};
        pg8::StaticOrder S3; S3.init(4, 16, G, G - 1 - bid - 64); EpiVWo E3{(bf16_t*)(ws + WS_VWOT)};
        pg8::gemm_phase(lds, g3, S3, E3);
    }
    }
    if (P.lo <= 4 && 4 < P.hi) GRID_SYNC();

    if (P.lo <= 5 && 5 <= P.hi) {
    {
        const int tid = opaque_tid();
        const bf16_t* pp = (const bf16_t*)(ws + WS_PP); bf16_t* cat = (bf16_t*)(ws + WS_A);
        for (int ch = bid; ch < 256; ch += G) {
            const int c = tid, win = 2 << (c >> 7), pos0 = (ch & 63) * 64; const size_t row0 = (size_t)ch * 64;
            float s = 0.f;
            for (int t = -(win - 1); t < 0; ++t) if (pos0 + t >= 0) s += bf2f(pp[(row0 + t) * 512 + c]);
            for (int t = 0; t < 64; ++t) {
                const float pv = bf2f(pp[(row0 + t) * 512 + c]); s += pv;
                const int pos = pos0 + t; const float cnt = (float)(pos + 1 < win ? pos + 1 : win);
                cat[(row0 + t) * 1024 + 512 + c] = f2bf(s / cnt - pv);
                if (pos - win + 1 >= 0) s -= bf2f(pp[(row0 + t - win + 1) * 512 + c]);
            }
        }
        for (int unit = bid; unit < 1024; unit += G) dn_prep_unit(P, lds, unit);
    }
    }
    if (P.lo <= 5 && 5 < P.hi) GRID_SYNC();

    if (P.lo <= 6 && 6 <= P.hi) {
    dn_scan(P, lds);
    }
    if (P.lo <= 6 && 6 < P.hi) GRID_SYNC();

    if (P.lo <= 7 && 7 <= P.hi) {
    {
        const int tid = opaque_tid(), lane = tid & 63, wave = tid >> 6;
        const bf16_t* ob = (const bf16_t*)(ws + WS_O); const bf16_t* zb = (const bf16_t*)(ws + WS_ZB); bf16_t* cat = (bf16_t*)(ws + WS_A);
        const float* nw = P.in[11] + (lane & 15) * 8;
        const f32x4 nw0 = *(const f32x4*)nw, nw1 = *(const f32x4*)(nw + 4);
        for (int row = bid * 8 + wave; row < MTOK; row += G * 8) {
            float o[8], z[8]; unpack8(*(const u32x4*)(ob + ((size_t)(((row >> 12) * 4 + (lane >> 4)) * 8 + ((lane & 15) >> 1)) * 4096 + (row & 4095)) * 16 + (lane & 1) * 8), o); unpack8(*(const u32x4*)(zb + (size_t)row * 512 + lane * 8), z);
            float ss = 0.f;
#pragma unroll
            for (int i = 0; i < 8; ++i) ss += o[i] * o[i];
            ss += __shfl_xor(ss, 1); ss += __shfl_xor(ss, 2); ss += __shfl_xor(ss, 4); ss += __shfl_xor(ss, 8);
            const float rs = 1.0f / sqrtf(ss * (1.0f / 128.0f) + 1e-6f);
            float v[8];
#pragma unroll
            for (int i = 0; i < 8; ++i) v[i] = o[i] * rs * (i < 4 ? nw0[i & 3] : nw1[i & 3]) * siluf_(z[i]);
            *(u32x4*)(cat + (size_t)row * 1024 + lane * 8) = pack8(v);
        }
    }
    }
    if (P.lo <= 7 && 7 < P.hi) GRID_SYNC();

    if (P.lo <= 8 && 8 <= P.hi) {
    {
        DescPlain g{(const bf16_t*)(ws + WS_A), (const bf16_t*)(ws + WS_CATW), 1024, 1024, 1024, 30, 0};
        pg8::StaticOrder S; S.init(64, 4, G, bid); EpiMerge E{(const bf16_t*)(ws + WS_G), (const bf16_t*)(ws + WS_G + 32 * MiB), (bf16_t*)(ws + WS_MERGED)};
        pg8::gemm_phase(lds, g, S, E);
    }
    }
    if (P.lo <= 8 && 8 < P.hi) GRID_SYNC();

    if (P.lo <= 9 && 9 <= P.hi) {
    {
        DescPlain g{(const bf16_t*)(ws + WS_MERGED), (const bf16_t*)(ws + WS_WMIXT), 1024, 1024, 1024, 30, 0};
        pg8::StaticOrder S; S.init(64, 4, G, bid); EpiResF32 E{xio, xio, 1.0f};
        pg8::gemm_phase(lds, g, S, E);
    }
    }
    if (P.lo <= 9 && 9 < P.hi) GRID_SYNC();

    if (P.lo <= 10 && 10 <= P.hi) {
    ln_phase(xio, (bf16_t*)(ws + WS_A), P.in[17], P.in[18]);
    __syncthreads();
    convert_ffn_weights((LAS float*)lds, P.in[27], P.in[28], P.in[29], ws);
    }
    if (P.lo <= 10 && 10 < P.hi) GRID_SYNC();

    if (P.lo <= 11 && 11 <= P.hi) {
    {
        DescPlain g{(const bf16_t*)(ws + WS_A), (const bf16_t*)(ws + WS_KQT), 1024, 1024, 1024, 4, (size_t)1024 * 1024};
        pg8::StaticOrder S; S.init(64, 4, G, bid); EpiSoftmax E{(bf16_t*)(ws + WS_PB)};
        pg8::gemm_phase(lds, g, S, E);
    }
    }
    if (P.lo <= 11 && 11 < P.hi) GRID_SYNC();

    if (P.lo <= 12 && 12 <= P.hi) {
    {
        DescPlain g{(const bf16_t*)(ws + WS_PB), (const bf16_t*)(ws + WS_VWOT), 1024, 1024, 1024, 4, (size_t)1024 * 1024};
        pg8::StaticOrder S; S.init(64, 4, G, bid); EpiResF32 E{xio, xio, 1.0f};
        pg8::gemm_phase(lds, g, S, E);
    }
    }
    if (P.lo <= 12 && 12 < P.hi) GRID_SYNC();

    if (P.lo <= 13 && 13 <= P.hi) {
    ln_phase(xio, (bf16_t*)(ws + WS_A), P.in[25], P.in[26]);
    }
    if (P.lo <= 13 && 13 < P.hi) GRID_SYNC();

    if (P.lo <= 14 && 14 <= P.hi) {
    {
        DescPlain g{(const bf16_t*)(ws + WS_A), (const bf16_t*)(ws + WS_FFNGU), 1024, 1024, 1024, 30, 0};
        pg8::StaticOrder S; S.init(64, 22, G, bid); EpiSwiglu E{(bf16_t*)(ws + WS_H)};
        pg8::gemm_phase(lds, g, S, E);
    }
    }
    if (P.lo <= 14 && 14 < P.hi) GRID_SYNC();

    if (P.lo <= 15 && 15 <= P.hi) {
    {
        DescPlain g{(const bf16_t*)(ws + WS_H), (const bf16_t*)(ws + WS_FFND), FF, FF, FF, 30, 0};
        pg8::StaticOrder S; S.init(64, 4, G, bid); EpiResF32 E{xio, xio, 0.5f};
        pg8::gemm_phase(lds, g, S, E);
    }
    }
    if (P.lo <= 15 && 15 < P.hi) GRID_SYNC();

    if (P.lo <= 16 && 16 <= P.hi) {
    ln_phase(xio, nullptr, P.in[30], P.in[31]);
    }
}

extern "C" void kernel_launch(void* const* d_in, const int* in_sizes, int n_in, void* d_out, int out_size, void* d_ws, size_t ws_size, hipStream_t stream) {
    static int grid_blocks = 0;
    if (!grid_blocks) {
        int dev = 0, cus = 0, per_cu = 0;
        hipGetDevice(&dev);
        hipDeviceGetAttribute(&cus, hipDeviceAttributeMultiprocessorCount, dev);
        if (hipFuncSetAttribute((const void*)fwd_megakernel, hipFuncAttributeMaxDynamicSharedMemorySize, LDS_BYTES) != hipSuccess) fprintf(stderr, "kernel_launch: hipFuncSetAttribute failed\n");
        if (hipOccupancyMaxActiveBlocksPerMultiprocessor(&per_cu, (const void*)fwd_megakernel, NTHR, LDS_BYTES) != hipSuccess || per_cu < 1) { fprintf(stderr, "kernel_launch: occupancy query gave %d\n", per_cu); per_cu = 1; }
        (void)hipGetLastError();
        grid_blocks = cus * per_cu;
        if (ws_size < WS_END) fprintf(stderr, "kernel_launch: workspace too small: %zu < %zu\n", ws_size, (size_t)WS_END);
    }
    KParams p{};
    for (int i = 0; i < 32; ++i) p.in[i] = (const float*)d_in[i];
    p.out = (float*)d_out; p.ws = (unsigned char*)d_ws;
    void* args[] = {&p};
    hipError_t e = hipSuccess;
#if PER_PHASE_LAUNCH
    for (int ph = 0; ph < 17 && e == hipSuccess; ++ph) { p.lo = ph; p.hi = ph;
        e = hipLaunchCooperativeKernel((const void*)fwd_megakernel, dim3(grid_blocks), dim3(NTHR), args, LDS_BYTES, stream); }
#else
    p.lo = 0; p.hi = 16;
    e = hipLaunchCooperativeKernel((const void*)fwd_megakernel, dim3(grid_blocks), dim3(NTHR), args, LDS_BYTES, stream);
#endif
    if (e != hipSuccess) fprintf(stderr, "cooperative launch failed: %s (grid %d)\n", hipGetErrorString(e), grid_blocks);
}
```

```cpp
#include <hip/hip_runtime.h>
#include <hip/hip_cooperative_groups.h>
#include <cstdio>
namespace cg = cooperative_groups;
#ifndef PER_PHASE_LAUNCH
#define PER_PHASE_LAUNCH 0
#endif

#define LAS __attribute__((address_space(3)))
typedef unsigned short bf16_t;
typedef short bf16x8 __attribute__((ext_vector_type(8)));
typedef float f32x4 __attribute__((ext_vector_type(4)));
typedef float f32x2 __attribute__((ext_vector_type(2)));
typedef unsigned u32x4 __attribute__((ext_vector_type(4)));
typedef unsigned u32x2 __attribute__((ext_vector_type(2)));

constexpr int MTOK = 16384, DM = 1024, FF = 2816, NTHR = 512;
constexpr int LDS_BYTES = 147456;
constexpr float ALPHA = 1.189207115002721f;

constexpr size_t MiB = 1u << 20;
constexpr size_t WS_FFNGU = 0;
constexpr size_t WS_FFND  = 11 * MiB;
constexpr size_t WS_WINT  = 16 * MiB + MiB / 2;
constexpr size_t WS_CATW  = WS_WINT + 9 * MiB;
constexpr size_t WS_WMIXT = WS_CATW + 2 * MiB;
constexpr size_t WS_WQ    = WS_WMIXT + 2 * MiB;
constexpr size_t WS_WKVT  = WS_WQ + 2 * MiB;
constexpr size_t WS_WOT   = WS_WKVT + 4 * MiB;
constexpr size_t WS_MB    = WS_WOT + 2 * MiB;
constexpr size_t WS_KV    = WS_MB + 2 * MiB;
constexpr size_t WS_KQT   = WS_KV + 4 * MiB;
constexpr size_t WS_VWOT  = WS_KQT + 8 * MiB;
constexpr size_t WS_SMALL = WS_VWOT + 8 * MiB;
constexpr size_t WS_HALO  = WS_SMALL + 1 * MiB;
constexpr size_t WS_A     = WS_HALO + 2 * MiB + MiB / 2;
constexpr size_t WS_H     = WS_A + 32 * MiB;
constexpr size_t WS_G     = WS_H + 88 * MiB;
constexpr size_t WS_END   = WS_G + 64 * MiB;
constexpr size_t WS_QKVB = WS_H, WS_ZB = WS_H + 48 * MiB, WS_PP = WS_H + 64 * MiB, WS_ATT = WS_H + 80 * MiB;
constexpr size_t WS_O = WS_PP, WS_MERGED = WS_H, WS_PB = WS_H, WS_WBUF = WS_FFNGU;
constexpr size_t WS_GARR = WS_SMALL, WS_BETA = WS_SMALL + 256 * 1024, WS_GL = WS_SMALL + 512 * 1024;

struct KParams { const float* in[32]; float* out; unsigned char* ws; int lo, hi; };

__device__ __forceinline__ int opaque_tid() { int t = threadIdx.x; asm volatile("" : "+v"(t)); return t; }
typedef __bf16 bf16x2_t __attribute__((ext_vector_type(2)));
__device__ __forceinline__ unsigned cvt_pk_bf16(float lo, float hi) { const f32x2 v = {lo, hi}; return __builtin_bit_cast(unsigned, __builtin_convertvector(v, bf16x2_t)); }
__device__ __forceinline__ bf16_t f2bf(float f) { return (bf16_t)(cvt_pk_bf16(f, 0.f) & 0xffffu); }
__device__ __forceinline__ float bf_lo(unsigned w) { return __uint_as_float(w << 16); }
__device__ __forceinline__ float bf_hi(unsigned w) { return __uint_as_float(w & 0xffff0000u); }
__device__ __forceinline__ float bf2f(bf16_t b) { return __uint_as_float(((unsigned)b) << 16); }
__device__ __forceinline__ float sigmoidf_(float x) { return __builtin_amdgcn_rcpf(1.0f + __expf(-x)); }
__device__ __forceinline__ float siluf_(float x) { return x * __builtin_amdgcn_rcpf(1.0f + __expf(-x)); }
__device__ __forceinline__ float wave_sum(float v) { v += __shfl_xor(v, 32); v += __shfl_xor(v, 16); v += __shfl_xor(v, 8); v += __shfl_xor(v, 4); v += __shfl_xor(v, 2); v += __shfl_xor(v, 1); return v; }
__device__ __forceinline__ void unpack8(const u32x4 w, float (&f)[8]) { f[0] = bf_lo(w.x); f[1] = bf_hi(w.x); f[2] = bf_lo(w.y); f[3] = bf_hi(w.y); f[4] = bf_lo(w.z); f[5] = bf_hi(w.z); f[6] = bf_lo(w.w); f[7] = bf_hi(w.w); }
__device__ __forceinline__ u32x4 pack8(const float (&f)[8]) { u32x4 w; w.x = cvt_pk_bf16(f[0], f[1]); w.y = cvt_pk_bf16(f[2], f[3]); w.z = cvt_pk_bf16(f[4], f[5]); w.w = cvt_pk_bf16(f[6], f[7]); return w; }

namespace pg8 {
constexpr int BM = 256, BK = 64, HALF = 128, HTB = HALF * BK * 2, STAGE_BYTES = 8 * HTB, NXCD = 8, WGM = 8;
__device__ __forceinline__ int lds_byte(int r, int c) { const int st = (r >> 4) * 2 + (c >> 5), rr = r & 15, cc = c & 31, ob = rr * 64 + cc * 2; return st * 1024 + (ob ^ (((ob >> 9) & 1) << 5)); }
__device__ __forceinline__ void stage_rc(int b, int& R, int& C) { const int st = b / 1024, sb = b % 1024, swz = sb ^ (((sb >> 9) & 1) << 5); R = (st >> 1) * 16 + swz / 64; C = (st & 1) * 32 + (swz % 64) / 2; }
__device__ __forceinline__ int perm32(int rho) { const int n = rho >> 4, i = rho & 15; return 8 * (i >> 2) + 4 * n + (i & 3); }
struct Unit { int pm, pn; };
struct StaticOrder {
    int nM, nN, nwg, G, c;
    __device__ void init(int nM_, int nN_, int G_, int c_) { nM = nM_; nN = nN_; nwg = nM * nN; G = G_; c = c_; }
    __device__ bool next(int i, Unit& u) const {
        if (c < 0) return false;
        const long L = (long)i * G + c; if (L >= nwg) return false;
        int wgid = (int)L; { const int q = nwg / NXCD, r = nwg % NXCD, xcd = wgid % NXCD, off = wgid / NXCD; wgid = (xcd < r ? xcd * (q + 1) : r * (q + 1) + (xcd - r) * q) + off; }
        const int nig = WGM * nN, gid = wgid / nig, fm = gid * WGM, gsz = (nM - fm) < WGM ? (nM - fm) : WGM;
        u.pm = fm + ((wgid % nig) % gsz); u.pn = (wgid % nig) / gsz; return true;
    }
};
template <class Desc, class Epi, class Sched>
__device__ __forceinline__ void gemm_phase(LAS unsigned char* lds, const Desc& g, const Sched& S, const Epi& E) {
    const int tid = opaque_tid(), wid = __builtin_amdgcn_readfirstlane(tid >> 6), lane = tid & 63, wr = wid >> 2, wc = wid & 3, fr = lane & 15, fq = lane >> 4;
    const int K = g.K, nt = K / BK;
    unsigned voffA[2], voffB[2];
#pragma unroll
    for (int i = 0; i < 2; ++i) { int R, C; stage_rc(tid * 16 + i * 8192, R, C); const int Rb = Epi::PERM ? ((R & ~31) + perm32(R & 31)) : R;
        voffA[i] = (unsigned)(R * g.lda + C) * 2u; voffB[i] = (unsigned)(Rb * g.ldb + C) * 2u; }
    const size_t kstep = (size_t)(BK * 2);
    const size_t hstepA = (size_t)HALF * g.lda * 2, hstepB = (size_t)HALF * g.ldb * 2;
    const unsigned ldsw = (unsigned)wid * 1024u;
    const int aoff = lds_byte(wr * 64 + fr, fq * 8), boff = lds_byte(wc * 32 + fr, fq * 8);
#define PG8_SA(b, h) (((b) * 2 + (h)) * HTB)
#define PG8_SB(b, h) ((4 + (b) * 2 + (h)) * HTB)
#define PG8_STAGE(bufoff, gbase, voff) do { _Pragma("unroll") for (int _i = 0; _i < 2; ++_i) \
        __builtin_amdgcn_global_load_lds((const unsigned*)((const char*)(gbase) + (voff)[_i]), (LAS unsigned*)(lds + (bufoff) + ldsw + _i * 8192), 16, 0, 0); } while (0)
#define PG8_LDA(dst, b, h) do { _Pragma("unroll") for (int m = 0; m < 4; ++m) _Pragma("unroll") for (int k = 0; k < 2; ++k) dst[m][k] = *(const LAS bf16x8*)(lds + PG8_SA(b, h) + aoff + m * 2048 + k * 1024); } while (0)
#define PG8_LDB(dst, b, h) do { _Pragma("unroll") for (int n = 0; n < 2; ++n) _Pragma("unroll") for (int k = 0; k < 2; ++k) dst[n][k] = *(const LAS bf16x8*)(lds + PG8_SB(b, h) + boff + n * 2048 + k * 1024); } while (0)
#define PG8_MMA(ai, bj, At, Bt) do { __builtin_amdgcn_s_setprio(1); _Pragma("unroll") for (int m = 0; m < 4; ++m) _Pragma("unroll") for (int n = 0; n < 2; ++n) _Pragma("unroll") for (int k = 0; k < 2; ++k) \
        acc[ai][bj][m][n] = __builtin_amdgcn_mfma_f32_16x16x32_bf16(Bt[n][k], At[m][k], acc[ai][bj][m][n], 0, 0, 0); __builtin_amdgcn_s_setprio(0); } while (0)
#define PG8_WAIT_V(n) asm volatile("s_waitcnt vmcnt(" #n ")" ::: "memory")
#define PG8_WAIT_L(n) asm volatile("s_waitcnt lgkmcnt(" #n ")" ::: "memory")
#define PG8_BAR __builtin_amdgcn_s_barrier()
#define PG8_SCHED __builtin_amdgcn_sched_barrier(0)
    Unit cur, nxt; int ui = 0;
    if (!S.next(0, cur)) return;
    f32x4 acc[2][2][4][2];
#pragma unroll
    for (int a = 0; a < 2; ++a)
#pragma unroll
        for (int b = 0; b < 2; ++b)
#pragma unroll
            for (int m = 0; m < 4; ++m)
#pragma unroll
                for (int n = 0; n < 2; ++n) acc[a][b][m][n] = (f32x4){0.f, 0.f, 0.f, 0.f};
    bf16x8 At[4][2], B0[2][2], B1[2][2];
    const char* cA = g.abase(cur); const char* cB = g.bbase(cur);
    PG8_STAGE(PG8_SB(0, 0), cB, voffB); PG8_STAGE(PG8_SA(0, 0), cA, voffA); PG8_STAGE(PG8_SB(0, 1), cB + hstepB, voffB); PG8_STAGE(PG8_SA(0, 1), cA + hstepA, voffA);
    if (wr == 1) PG8_BAR;
    PG8_WAIT_V(4); PG8_BAR;
    PG8_STAGE(PG8_SB(1, 0), cB + kstep, voffB); PG8_STAGE(PG8_SA(1, 0), cA + kstep, voffA); PG8_STAGE(PG8_SB(1, 1), cB + hstepB + kstep, voffB);
    PG8_WAIT_V(6); PG8_BAR;
    for (;;) {
        const bool has_next = S.next(ui + 1, nxt);
        const char* nA = has_next ? g.abase(nxt) : cA; const char* nB = has_next ? g.bbase(nxt) : cB;
        for (int t = 0; t < nt; t += 2) {
            const bool last = (t == nt - 2);
            const char* a1 = cA + (size_t)(t + 1) * kstep;
            const char* a2 = last ? nA : cA + (size_t)(t + 2) * kstep; const char* b2 = last ? nB : cB + (size_t)(t + 2) * kstep;
            const char* a3 = a2 + kstep; const char* b3 = b2 + kstep;
            if constexpr (Epi::HAS_MID) { if (t == nt / 2) E.mid(acc, cur, wr, wc, fr, fq); }
            PG8_LDB(B0, 0, 0); PG8_SCHED; PG8_LDA(At, 0, 0); PG8_STAGE(PG8_SA(1, 1), a1 + hstepA, voffA);
            PG8_WAIT_L(8); PG8_BAR; PG8_WAIT_L(0); PG8_MMA(0, 0, At, B0); PG8_BAR; PG8_SCHED;
            PG8_LDB(B1, 0, 1); PG8_STAGE(PG8_SB(0, 0), b2, voffB);
            PG8_BAR; PG8_WAIT_L(0); PG8_MMA(0, 1, At, B1); PG8_BAR;
            PG8_LDA(At, 0, 1); PG8_STAGE(PG8_SA(0, 0), a2, voffA);
            PG8_BAR; PG8_WAIT_L(0); PG8_MMA(1, 0, At, B0); PG8_BAR; PG8_SCHED;
            PG8_STAGE(PG8_SB(0, 1), b2 + hstepB, voffB);
            PG8_WAIT_V(6); PG8_BAR; PG8_MMA(1, 1, At, B1); PG8_BAR;
            PG8_LDB(B0, 1, 0); PG8_SCHED; PG8_LDA(At, 1, 0); PG8_STAGE(PG8_SA(0, 1), a2 + hstepA, voffA);
            PG8_WAIT_L(8); PG8_BAR; PG8_WAIT_L(0); PG8_MMA(0, 0, At, B0); PG8_BAR; PG8_SCHED;
            PG8_LDB(B1, 1, 1); PG8_STAGE(PG8_SB(1, 0), b3, voffB);
            PG8_BAR; PG8_WAIT_L(0); PG8_MMA(0, 1, At, B1); PG8_BAR;
            PG8_LDA(At, 1, 1); PG8_STAGE(PG8_SA(1, 0), a3, voffA);
            PG8_BAR; PG8_WAIT_L(0); PG8_MMA(1, 0, At, B0); PG8_BAR; PG8_SCHED;
            PG8_STAGE(PG8_SB(1, 1), b3 + hstepB, voffB);
            PG8_WAIT_V(6); PG8_BAR; PG8_MMA(1, 1, At, B1); PG8_BAR;
        }
        if constexpr (!Epi::AFTER_DRAIN) { E(acc, cur, wr, wc, fr, fq); }
        if (!has_next) break;
#pragma unroll
        for (int a = 0; a < 2; ++a)
#pragma unroll
            for (int b = 0; b < 2; ++b)
#pragma unroll
                for (int m = 0; m < 4; ++m)
#pragma unroll
                    for (int n = 0; n < 2; ++n) acc[a][b][m][n] = (f32x4){0.f, 0.f, 0.f, 0.f};
        cur = nxt; cA = nA; cB = nB; ++ui;
    }
    PG8_WAIT_V(0);
    if (wr == 0) PG8_BAR;
    PG8_BAR;
    if constexpr (Epi::AFTER_DRAIN) { E.fused(acc, cur, wr, wc, fr, fq, lds, wid, lane); }
#undef PG8_SA
#undef PG8_SB
#undef PG8_STAGE
#undef PG8_LDA
#undef PG8_LDB
#undef PG8_MMA
#undef PG8_WAIT_V
#undef PG8_WAIT_L
#undef PG8_BAR
#undef PG8_SCHED
}
}
using pg8::Unit;
typedef f32x4 AccT[2][2][4][2];

struct DescPlain {
    const bf16_t* A; const bf16_t* Bt; int K, lda, ldb; int bshift; size_t bstride;
    __device__ __forceinline__ const char* abase(const Unit& u) const { return (const char*)(A + (size_t)u.pm * 256 * lda); }
    __device__ __forceinline__ const char* bbase(const Unit& u) const { return (const char*)(Bt + (size_t)u.pn * 256 * ldb + (size_t)(u.pm >> bshift) * bstride); }
};
struct DescKQ {
    const bf16_t* KV; const bf16_t* Wq; int K, lda, ldb;
    __device__ __forceinline__ const char* abase(const Unit& u) const { return (const char*)(KV + (size_t)(u.pm >> 2) * 256 * 2048 + (u.pm & 3) * 256); }
    __device__ __forceinline__ const char* bbase(const Unit& u) const { return (const char*)(Wq + (size_t)u.pn * 256 * 1024 + (u.pm & 3) * 256); }
};
struct DescVWo {
    const bf16_t* WoT; const bf16_t* KV; int K, lda, ldb;
    __device__ __forceinline__ const char* abase(const Unit& u) const { return (const char*)(WoT + (size_t)u.pm * 256 * 1024 + (u.pn & 3) * 256); }
    __device__ __forceinline__ const char* bbase(const Unit& u) const { return (const char*)(KV + (size_t)(u.pn >> 2) * 256 * 2048 + 1024 + (u.pn & 3) * 256); }
};

__device__ __forceinline__ void store_tile_bf16(const AccT& acc, bf16_t* tile00, int ldc, float scale, bool sig, int wr, int wc, int fr, int fq) {
    bf16_t* p0 = tile00 + (size_t)(wr * 64 + fr) * ldc + wc * 32 + 8 * fq;
#pragma unroll
    for (int ai = 0; ai < 2; ++ai)
#pragma unroll
        for (int m = 0; m < 4; ++m) { bf16_t* rowp = p0 + (size_t)(ai * 128 + m * 16) * ldc;
#pragma unroll
            for (int bj = 0; bj < 2; ++bj) { f32x4 v0 = acc[ai][bj][m][0] * scale, v1 = acc[ai][bj][m][1] * scale;
                if (sig) {
#pragma unroll
                    for (int j = 0; j < 4; ++j) { v0[j] = sigmoidf_(v0[j]); v1[j] = sigmoidf_(v1[j]); } }
                u32x4 w; w.x = cvt_pk_bf16(v0[0], v0[1]); w.y = cvt_pk_bf16(v0[2], v0[3]); w.z = cvt_pk_bf16(v1[0], v1[1]); w.w = cvt_pk_bf16(v1[2], v1[3]);
                *(u32x4*)(rowp + bj * 128) = w; }
            asm volatile("" ::: "memory"); }
}
struct EpiSwiglu {
    static constexpr bool PERM = false, AFTER_DRAIN = false, HAS_MID = false;
    bf16_t* H;
    __device__ __forceinline__ void operator()(const AccT& acc, const Unit& u, int wr, int wc, int fr, int fq) const {
        const int row0 = u.pm * 256 + wr * 64 + fr, col0 = u.pn * 128 + wc * 16 + 4 * fq;
#pragma unroll
        for (int ai = 0; ai < 2; ++ai)
#pragma unroll
            for (int m = 0; m < 4; ++m) { bf16_t* rowp = H + (size_t)(row0 + ai * 128 + m * 16) * FF + col0;
#pragma unroll
                for (int bj = 0; bj < 2; ++bj) { const f32x4 gt = acc[ai][bj][m][0], up = acc[ai][bj][m][1]; f32x4 h;
#pragma unroll
                    for (int j = 0; j < 4; ++j) h[j] = siluf_(gt[j]) * up[j];
                    u32x2 w; w.x = cvt_pk_bf16(h[0], h[1]); w.y = cvt_pk_bf16(h[2], h[3]); *(u32x2*)(rowp + bj * 64) = w; } }
    }
};
struct EpiResF32 {
    static constexpr bool PERM = false, AFTER_DRAIN = false, HAS_MID = false;
    const float* res; float* out; float scale;
    __device__ __forceinline__ void operator()(const AccT& acc, const Unit& u, int wr, int wc, int fr, int fq) const {
        const int row0 = u.pm * 256 + wr * 64 + fr, col0 = u.pn * 256 + wc * 32 + 4 * fq;
#pragma unroll
        for (int ai = 0; ai < 2; ++ai)
#pragma unroll
            for (int m = 0; m < 4; ++m) { const size_t off = (size_t)(row0 + ai * 128 + m * 16) * DM + col0;
                f32x4 r[2][2];
#pragma unroll
                for (int bj = 0; bj < 2; ++bj)
#pragma unroll
                    for (int n = 0; n < 2; ++n) r[bj][n] = *(const f32x4*)(res + off + bj * 128 + n * 16);
#pragma unroll
                for (int bj = 0; bj < 2; ++bj)
#pragma unroll
                    for (int n = 0; n < 2; ++n) *(f32x4*)(out + off + bj * 128 + n * 16) = r[bj][n] * ALPHA + acc[ai][bj][m][n] * scale;
                asm volatile("" ::: "memory"); }
    }
};
struct EpiWin {
    static constexpr bool PERM = true, AFTER_DRAIN = false, HAS_MID = false;
    unsigned char* ws;
    __device__ __forceinline__ void operator()(const AccT& acc, const Unit& u, int wr, int wc, int fr, int fq) const {
        const int pn = u.pn; const size_t r0 = (size_t)u.pm * 256;
        size_t boff; int ldc, ct;
        if (pn < 6) { boff = WS_QKVB; ldc = 1536; ct = pn; }
        else if (pn < 8) { boff = WS_ZB; ldc = 512; ct = pn - 6; }
        else if (pn < 10) { boff = WS_PP; ldc = 512; ct = pn - 8; }
        else if (pn < 14) { boff = WS_G; ldc = 1024; ct = pn - 10; }
        else { boff = WS_G + 32 * MiB; ldc = 1024; ct = pn - 14; }
        store_tile_bf16(acc, (bf16_t*)(ws + boff) + r0 * ldc + ct * 256, ldc, 1.f, pn >= 10, wr, wc, fr, fq);
        if (pn < 6 && fr >= 13) {
            bf16_t* halo = (bf16_t*)(ws + WS_HALO);
#pragma unroll
            for (int ai = 0; ai < 2; ++ai) { const int row = u.pm * 256 + ai * 128 + wr * 64 + 48 + fr;
                bf16_t* rowp = halo + (size_t)((row >> 6) * 3 + (row & 63) - 61) * 1536 + pn * 256 + wc * 32 + 8 * fq;
#pragma unroll
                for (int bj = 0; bj < 2; ++bj) { const f32x4 v0 = acc[ai][bj][3][0], v1 = acc[ai][bj][3][1];
                    u32x4 w; w.x = cvt_pk_bf16(v0[0], v0[1]); w.y = cvt_pk_bf16(v0[2], v0[3]); w.z = cvt_pk_bf16(v1[0], v1[1]); w.w = cvt_pk_bf16(v1[2], v1[3]);
                    *(u32x4*)(rowp + bj * 128) = w; } }
        }
    }
};
struct EpiKV {
    static constexpr bool PERM = true, AFTER_DRAIN = false, HAS_MID = false;
    bf16_t* KV;
    __device__ __forceinline__ void operator()(const AccT& acc, const Unit& u, int wr, int wc, int fr, int fq) const {
        store_tile_bf16(acc, KV + (size_t)u.pm * 256 * 2048 + u.pn * 256, 2048, 1.f, false, wr, wc, fr, fq); }
};
struct EpiKQ {
    static constexpr bool PERM = true, AFTER_DRAIN = false, HAS_MID = false;
    bf16_t* KQT;
    __device__ __forceinline__ void operator()(const AccT& acc, const Unit& u, int wr, int wc, int fr, int fq) const {
        store_tile_bf16(acc, KQT + (size_t)u.pm * 256 * 1024 + u.pn * 256, 1024, 0.0625f, false, wr, wc, fr, fq); }
};
struct EpiVWo {
    static constexpr bool PERM = true, AFTER_DRAIN = false, HAS_MID = false;
    bf16_t* VWOT;
    __device__ __forceinline__ void operator()(const AccT& acc, const Unit& u, int wr, int wc, int fr, int fq) const {
        store_tile_bf16(acc, VWOT + (size_t)(u.pn >> 2) * 1024 * 1024 + (size_t)u.pm * 256 * 1024 + (u.pn & 3) * 256, 1024, 1.f, false, wr, wc, fr, fq); }
};
struct EpiMerge {
    static constexpr bool PERM = true, AFTER_DRAIN = false, HAS_MID = true;
    const bf16_t* GDN; const bf16_t* GPOOL; bf16_t* MERGED;
    __device__ __forceinline__ void mid(AccT& acc, const Unit& u, int wr, int wc, int fr, int fq) const {
        unsigned rb = (unsigned)(u.pm * 256 + wr * 64 + fr); asm volatile("" : "+v"(rb));
        const size_t base = (size_t)rb * 1024 + u.pn * 256 + wc * 32 + 8 * fq;
#pragma unroll
        for (int ai = 0; ai < 2; ++ai)
#pragma unroll
            for (int m = 0; m < 4; ++m) {
#pragma unroll
                for (int bj = 0; bj < 2; ++bj) { const size_t off = base + (size_t)(ai * 128 + m * 16) * 1024 + bj * 128;
                    const u32x4 g1 = *(const u32x4*)(GDN + off), g2 = *(const u32x4*)(GPOOL + off); float a[8], b[8]; unpack8(g1, a); unpack8(g2, b);
#pragma unroll
                    for (int j = 0; j < 4; ++j) { acc[ai][bj][m][0][j] *= a[j] * __builtin_amdgcn_rcpf(fmaxf(b[j], 1e-30f)); acc[ai][bj][m][1][j] *= a[4 + j] * __builtin_amdgcn_rcpf(fmaxf(b[4 + j], 1e-30f)); }
                    asm volatile("" ::: "memory"); } }
    }
    __device__ __forceinline__ void operator()(const AccT& acc, const Unit& u, int wr, int wc, int fr, int fq) const {
        const size_t base = (size_t)(u.pm * 256 + wr * 64 + fr) * 1024 + u.pn * 256 + wc * 32 + 8 * fq;
#pragma unroll
        for (int ai = 0; ai < 2; ++ai)
#pragma unroll
            for (int m = 0; m < 4; ++m) {
#pragma unroll
                for (int bj = 0; bj < 2; ++bj) { const size_t off = base + (size_t)(ai * 128 + m * 16) * 1024 + bj * 128;
                    const u32x4 g2 = *(const u32x4*)(GPOOL + off); float b[8]; unpack8(g2, b);
                    const f32x4 v0 = acc[ai][bj][m][0], v1 = acc[ai][bj][m][1];
                    u32x4 w; w.x = cvt_pk_bf16(v0[0] * b[0], v0[1] * b[1]); w.y = cvt_pk_bf16(v0[2] * b[2], v0[3] * b[3]); w.z = cvt_pk_bf16(v1[0] * b[4], v1[1] * b[5]); w.w = cvt_pk_bf16(v1[2] * b[6], v1[3] * b[7]);
                    *(u32x4*)(MERGED + off) = w; }
                asm volatile("" ::: "memory"); }
    }
};
struct EpiSoftmax {
    static constexpr bool PERM = true, AFTER_DRAIN = true, HAS_MID = false;
    bf16_t* PB;
    __device__ __forceinline__ void fused(AccT& acc, const Unit& u, int wr, int wc, int fr, int fq, LAS unsigned char* lds, int wid, int lane) const {
        LAS f32x2* P = (LAS f32x2*)lds;
#pragma unroll
        for (int ai = 0; ai < 2; ++ai)
#pragma unroll
            for (int m = 0; m < 4; ++m) {
                float mx = -3.0e38f;
#pragma unroll
                for (int bj = 0; bj < 2; ++bj)
#pragma unroll
                    for (int n = 0; n < 2; ++n)
#pragma unroll
                        for (int j = 0; j < 4; ++j) mx = fmaxf(mx, acc[ai][bj][m][n][j]);
                mx = fmaxf(mx, __shfl_xor(mx, 16)); mx = fmaxf(mx, __shfl_xor(mx, 32));
                float s = 0.f;
#pragma unroll
                for (int bj = 0; bj < 2; ++bj)
#pragma unroll
                    for (int n = 0; n < 2; ++n)
#pragma unroll
                        for (int j = 0; j < 4; ++j) s += __expf(acc[ai][bj][m][n][j] - mx);
                s += __shfl_xor(s, 16); s += __shfl_xor(s, 32);
                if (fq == 0) P[(ai * 128 + wr * 64 + m * 16 + fr) * 4 + wc] = (f32x2){mx, s};
            }
        __syncthreads();
#pragma unroll
        for (int ai = 0; ai < 2; ++ai)
#pragma unroll
            for (int m = 0; m < 4; ++m) { const int r = ai * 128 + wr * 64 + m * 16 + fr;
                const f32x2 p0 = P[r * 4 + 0], p1 = P[r * 4 + 1], p2 = P[r * 4 + 2], p3 = P[r * 4 + 3];
                const float M = fmaxf(fmaxf(p0.x, p1.x), fmaxf(p2.x, p3.x));
                const float S = p0.y * __expf(p0.x - M) + p1.y * __expf(p1.x - M) + p2.y * __expf(p2.x - M) + p3.y * __expf(p3.x - M);
                const float inv = 1.0f / S;
                bf16_t* rowp = PB + (size_t)(u.pm * 256 + r) * 1024 + u.pn * 256 + wc * 32 + 8 * fq;
#pragma unroll
                for (int bj = 0; bj < 2; ++bj) { float v[8];
#pragma unroll
                    for (int j = 0; j < 4; ++j) { v[j] = __expf(acc[ai][bj][m][0][j] - M) * inv; v[4 + j] = __expf(acc[ai][bj][m][1][j] - M) * inv; }
                    *(u32x4*)(rowp + bj * 128) = pack8(v); } }
    }
};

template <int MODE>
__device__ __forceinline__ void transpose_job(LAS float* tile, int K, int N, int src_ld, bf16_t* out, int out_ld, const float* s0, const float* s1, int rot) {
    const int tid = opaque_tid(), tk = K / 64, nt = tk * (N / 64);
    for (int t = (int)((blockIdx.x + rot) % gridDim.x); t < nt; t += gridDim.x) {
        const int k0 = (t % tk) * 64, n0 = (t / tk) * 64;
        { const int nl = tid & 63, kl = tid >> 6, n = n0 + nl; const float* cp;
          if (MODE == 0) cp = s0 + n;
          else if (MODE == 1) { const int w = n & 31, G = n >> 5; cp = ((w < 16) ? s0 : s1) + G * 16 + (w & 15); }
          else if (MODE == 2) cp = s0 + (n < 2048 ? n : n + 8);
          else cp = n < 1024 ? s0 + n : s1 + (n - 1024);
#pragma unroll
          for (int kk = 0; kk < 8; ++kk) { const int k = kk * 8 + kl; tile[k * 65 + nl] = cp[(size_t)(k0 + k) * src_ld]; } }
        __syncthreads();
        { const int nl = tid >> 3, ks = tid & 7; float v[8];
#pragma unroll
          for (int j = 0; j < 8; ++j) v[j] = tile[(ks * 8 + j) * 65 + nl];
          *(u32x4*)(out + (size_t)(n0 + nl) * out_ld + k0 + ks * 8) = pack8(v); }
        __syncthreads();
    }
}
__device__ __forceinline__ void convert_ffn_weights(LAS float* tile, const float* wg, const float* wu, const float* wd, unsigned char* ws) {
    transpose_job<1>(tile, 1024, 5632, FF, (bf16_t*)(ws + WS_FFNGU), 1024, wg, wu, 0);
    transpose_job<0>(tile, FF, 1024, 1024, (bf16_t*)(ws + WS_FFND), FF, wd, nullptr, 128);
}
__device__ __forceinline__ void ln_row(const float* src, const float* g, const float* b, int lane, f32x4 (&y)[4]) {
    f32x4 v[4];
#pragma unroll
    for (int j = 0; j < 4; ++j) v[j] = *(const f32x4*)(src + j * 256 + lane * 4);
    float s = 0.f;
#pragma unroll
    for (int j = 0; j < 4; ++j) s += (v[j][0] + v[j][1]) + (v[j][2] + v[j][3]);
    const float mean = wave_sum(s) * (1.0f / 1024.0f);
    float q = 0.f;
#pragma unroll
    for (int j = 0; j < 4; ++j) { const f32x4 d = v[j] - mean; q += (d[0] * d[0] + d[1] * d[1]) + (d[2] * d[2] + d[3] * d[3]); }
    const float rstd = 1.0f / sqrtf(wave_sum(q) * (1.0f / 1024.0f) + 1e-5f);
#pragma unroll
    for (int j = 0; j < 4; ++j) { const f32x4 gg = *(const f32x4*)(g + j * 256 + lane * 4), bb = *(const f32x4*)(b + j * 256 + lane * 4); y[j] = (v[j] - mean) * rstd * gg + bb; }
}
__device__ __forceinline__ void store_row_bf16(bf16_t* dst, int lane, const f32x4 (&y)[4]) {
#pragma unroll
    for (int j = 0; j < 4; ++j) { u32x2 w; w.x = cvt_pk_bf16(y[j][0], y[j][1]); w.y = cvt_pk_bf16(y[j][2], y[j][3]); *(u32x2*)(dst + j * 256 + lane * 4) = w; }
}
__device__ __forceinline__ void ln_phase(float* xio, bf16_t* xb, const float* g, const float* b) {
    const int tid = opaque_tid(), lane = tid & 63, wave = tid >> 6;
    for (int row = blockIdx.x * 8 + wave; row < MTOK; row += gridDim.x * 8) {
        f32x4 y[4]; ln_row(xio + (size_t)row * DM, g, b, lane, y);
#pragma unroll
        for (int j = 0; j < 4; ++j) *(f32x4*)(xio + (size_t)row * DM + j * 256 + lane * 4) = y[j];
        if (xb) store_row_bf16(xb + (size_t)row * DM, lane, y);
    }
}

__device__ __forceinline__ void dn_prep_unit(const KParams& P, LAS unsigned char* lds, int unit) {
    const int tid = opaque_tid(), lane = tid & 63, wave = tid >> 6;
    const int h = unit & 3, gchunk = unit >> 2, chunk = gchunk & 63; const size_t row0 = (size_t)gchunk * 64;
    bf16_t* qkvb = (bf16_t*)(P.ws + WS_QKVB); const bf16_t* halo = (const bf16_t*)(P.ws + WS_HALO);
    const float* garr = (const float*)(P.ws + WS_GARR); const float* betaarr = (const float*)(P.ws + WS_BETA);
    LAS unsigned char* KB16 = lds; LAS unsigned char* QB16 = lds + 17408; LAS unsigned char* KDT = lds + 34816;
    LAS float* RHS = (LAS float*)(lds + 53248); LAS float* AM = (LAS float*)(lds + 118784);
    LAS float* GC = (LAS float*)(lds + 135168); LAS float* BT = GC + 64;
    if (tid < 64) { float v = garr[(row0 + tid) * 4 + h];
#pragma unroll
        for (int off = 1; off < 64; off <<= 1) { const float t = __shfl_up(v, off); if (lane >= off) v += t; }
        GC[tid] = v; BT[tid] = betaarr[(row0 + tid) * 4 + h]; }
    __syncthreads();
    const int r = tid >> 3, seg = tid & 7, ch0 = seg * 16;
    const float gc_r = GC[r], beta_r = BT[r], gl = GC[63], egc_r = __expf(gc_r), ekd_r = __expf(gl - gc_r);
    float qn[16];
#pragma unroll
    for (int part = 0; part < 3; ++part) {
        const int col0 = part * 512 + h * 128 + ch0;
        float y[16];
#pragma unroll
        for (int c = 0; c < 16; ++c) y[c] = 0.f;
#pragma unroll
        for (int j = 0; j < 4; ++j) {
            const int tt = r - 3 + j; u32x4 w0 = (u32x4){0u, 0u, 0u, 0u}, w1 = w0;
            if (tt >= 0) { const bf16_t* p = qkvb + (row0 + tt) * 1536 + col0; w0 = *(const u32x4*)p; w1 = *(const u32x4*)(p + 8); }
            else if (chunk > 0) { const bf16_t* p = halo + (size_t)((gchunk - 1) * 3 + tt + 3) * 1536 + col0; w0 = *(const u32x4*)p; w1 = *(const u32x4*)(p + 8); }
            float x[16]; { float a[8], b[8]; unpack8(w0, a); unpack8(w1, b);
#pragma unroll
                for (int c = 0; c < 8; ++c) { x[c] = a[c]; x[8 + c] = b[c]; } }
            const float* cw = P.in[8] + j * 1536 + col0;
#pragma unroll
            for (int c4 = 0; c4 < 4; ++c4) { const f32x4 wv = *(const f32x4*)(cw + c4 * 4);
#pragma unroll
                for (int e = 0; e < 4; ++e) y[c4 * 4 + e] += wv[e] * x[c4 * 4 + e]; }
        }
        float ss = 0.f;
#pragma unroll
        for (int c = 0; c < 16; ++c) { y[c] = siluf_(y[c]); ss += y[c] * y[c]; }
        ss += __shfl_xor(ss, 1); ss += __shfl_xor(ss, 2); ss += __shfl_xor(ss, 4);
        if (part == 0) {
            const float sc = (1.0f / sqrtf(ss + 1e-6f)) * 0.08838834764831845f;
            float v[8];
#pragma unroll
            for (int c = 0; c < 16; ++c) qn[c] = y[c] * sc;
#pragma unroll
            for (int c = 0; c < 8; ++c) v[c] = qn[c];
            *(LAS u32x4*)(QB16 + r * 272 + ch0 * 2) = pack8(v);
#pragma unroll
            for (int c = 0; c < 8; ++c) v[c] = qn[8 + c];
            *(LAS u32x4*)(QB16 + r * 272 + ch0 * 2 + 16) = pack8(v);
        } else if (part == 1) {
            const float sc = 1.0f / sqrtf(ss + 1e-6f);
            float v[8];
#pragma unroll
            for (int c = 0; c < 16; ++c) y[c] *= sc;
#pragma unroll
            for (int c = 0; c < 8; ++c) v[c] = y[c];
            *(LAS u32x4*)(KB16 + r * 272 + ch0 * 2) = pack8(v);
#pragma unroll
            for (int c = 0; c < 8; ++c) v[c] = y[8 + c];
            *(LAS u32x4*)(KB16 + r * 272 + ch0 * 2 + 16) = pack8(v);
            const float bw = beta_r * egc_r;
#pragma unroll
            for (int c4 = 0; c4 < 4; ++c4) *(LAS f32x4*)(RHS + r * 256 + 128 + ch0 + c4 * 4) = (f32x4){y[c4 * 4] * bw, y[c4 * 4 + 1] * bw, y[c4 * 4 + 2] * bw, y[c4 * 4 + 3] * bw};
#pragma unroll
            for (int c = 0; c < 16; ++c) *(LAS bf16_t*)(KDT + (ch0 + c) * 144 + r * 2) = f2bf(y[c] * ekd_r);
        } else {
#pragma unroll
            for (int c4 = 0; c4 < 4; ++c4) *(LAS f32x4*)(RHS + r * 256 + ch0 + c4 * 4) = (f32x4){y[c4 * 4] * beta_r, y[c4 * 4 + 1] * beta_r, y[c4 * 4 + 2] * beta_r, y[c4 * 4 + 3] * beta_r};
        }
    }
    __syncthreads();
    {
        float v[8]; bf16_t* p = qkvb + (row0 + r) * 1536 + h * 128 + ch0;
#pragma unroll
        for (int c = 0; c < 8; ++c) v[c] = qn[c] * egc_r;
        *(u32x4*)p = pack8(v);
#pragma unroll
        for (int c = 0; c < 8; ++c) v[c] = qn[8 + c] * egc_r;
        *(u32x4*)(p + 8) = pack8(v);
    }
#pragma unroll
    for (int i = 0; i < 2; ++i) {
        const int idx = tid + i * 512, d = idx >> 3, pc = idx & 7;
        *(u32x4*)(qkvb + (row0 + (d >> 1)) * 1536 + 512 + h * 128 + (d & 1) * 64 + pc * 8) = *(const LAS u32x4*)(KDT + d * 144 + pc * 16);
    }
    {
        const int fr = lane & 15, fq = lane >> 4; const bool isA = wave < 4; const int ti = wave & 3;
        LAS unsigned char* X = isA ? KB16 : QB16;
        bf16_t* attb = (bf16_t*)(P.ws + WS_ATT) + (size_t)unit * 4096;
#pragma unroll
        for (int tj = 0; tj < 4; ++tj) {
            f32x4 acc = (f32x4){0.f, 0.f, 0.f, 0.f};
#pragma unroll
            for (int kk = 0; kk < 4; ++kk) {
                const bf16x8 a = *(const LAS bf16x8*)(X + (ti * 16 + fr) * 272 + (kk * 32 + fq * 8) * 2);
                const bf16x8 b = *(const LAS bf16x8*)(KB16 + (tj * 16 + fr) * 272 + (kk * 32 + fq * 8) * 2);
                acc = __builtin_amdgcn_mfma_f32_16x16x32_bf16(a, b, acc, 0, 0, 0);
            }
            const int jj = tj * 16 + fr; const float gcj = GC[jj];
#pragma unroll
            for (int j = 0; j < 4; ++j) { const int i = ti * 16 + fq * 4 + j; const float gci = GC[i];
                if (isA) AM[i * 64 + jj] = (i > jj) ? BT[i] * acc[j] * __expf(gci - gcj) : 0.f;
                else attb[i * 64 + jj] = f2bf((i >= jj) ? acc[j] * __expf(gci - gcj) : 0.f); }
        }
    }
    __syncthreads();
    if (tid < 256) {
        float sol[64]; int zv = 0; asm volatile("" : "+v"(zv));
        const LAS float* AMv = AM + zv;
#pragma unroll
        for (int i = 0; i < 64; ++i) {
            float s = RHS[i * 256 + tid];
#pragma unroll
            for (int j4 = 0; j4 < (i + 3) / 4; ++j4) { const f32x4 a = *(const LAS f32x4*)(AMv + i * 64 + j4 * 4);
#pragma unroll
                for (int e = 0; e < 4; ++e) if (j4 * 4 + e < i) s -= a[e] * sol[j4 * 4 + e]; }
            sol[i] = s;
        }
        if (tid < 128) {
#pragma unroll
            for (int i = 0; i < 64; ++i) qkvb[(row0 + i) * 1536 + 1024 + h * 128 + tid] = f2bf(sol[i]);
        } else { bf16_t* wb = (bf16_t*)(P.ws + WS_WBUF);
#pragma unroll
            for (int i = 0; i < 64; ++i) wb[(row0 + i) * 512 + h * 128 + (tid - 128)] = f2bf(sol[i]);
        }
    }
    if (tid == 0) ((float*)(P.ws + WS_GL))[unit * 32] = gl;
    __syncthreads();
}

__device__ __forceinline__ void dn_scan(const KParams& P, LAS unsigned char* lds) {
    if (blockIdx.x >= 128) return;
    const int tid = opaque_tid(), lane = tid & 63, wave = tid >> 6, fr = lane & 15, fq = lane >> 4;
    const int bh = blockIdx.x >> 3, es = blockIdx.x & 7, b = bh >> 2, h = bh & 3, e0 = es * 16;
    const bf16_t* qkvb = (const bf16_t*)(P.ws + WS_QKVB); const bf16_t* wbuf = (const bf16_t*)(P.ws + WS_WBUF);
    const bf16_t* attb = (const bf16_t*)(P.ws + WS_ATT); const float* glarr = (const float*)(P.ws + WS_GL);
    bf16_t* obuf = (bf16_t*)(P.ws + WS_O);
    constexpr int OFF_W = 0, OFF_QD = 17408, OFF_KDT = 34816, OFF_ATT = 53248, OFF_U = 62464, BUFSZ = 64512;
    LAS unsigned char* ST = lds + 2 * BUFSZ; LAS unsigned char* VNT = ST + 4352;
    for (int i = tid; i < 4352 / 4; i += NTHR) ((LAS unsigned*)ST)[i] = 0u;
    u32x4 rW[2], rQ[2], rK[2], rA, rU;
    const int wr_ = tid >> 4, wc_ = tid & 15;
    const int kd_ = tid >> 3, kp_ = tid & 7;
    const int ar_ = tid >> 3, ap_ = tid & 7;
    const int ur_ = tid >> 1, up_ = tid & 1;
#define SCAN_LOAD(n) do { const int gch = b * 64 + (n); const size_t r0 = (size_t)gch * 64; const int un = gch * 4 + h; \
        _Pragma("unroll") for (int i = 0; i < 2; ++i) { const int rr = wr_ + i * 32; \
            rW[i] = *(const u32x4*)(wbuf + (r0 + rr) * 512 + h * 128 + wc_ * 8); \
            rQ[i] = *(const u32x4*)(qkvb + (r0 + rr) * 1536 + h * 128 + wc_ * 8); \
            const int d = kd_ + i * 64; rK[i] = *(const u32x4*)(qkvb + (r0 + (d >> 1)) * 1536 + 512 + h * 128 + (d & 1) * 64 + kp_ * 8); } \
        rA = *(const u32x4*)(attb + (size_t)un * 4096 + ar_ * 64 + ap_ * 8); \
        if (tid < 128) rU = *(const u32x4*)(qkvb + (r0 + ur_) * 1536 + 1024 + h * 128 + e0 + up_ * 8); } while (0)
#define SCAN_STORE(buf) do { LAS unsigned char* B_ = lds + (buf) * BUFSZ; \
        _Pragma("unroll") for (int i = 0; i < 2; ++i) { const int rr = wr_ + i * 32; \
            *(LAS u32x4*)(B_ + OFF_W + rr * 272 + wc_ * 16) = rW[i]; *(LAS u32x4*)(B_ + OFF_QD + rr * 272 + wc_ * 16) = rQ[i]; \
            *(LAS u32x4*)(B_ + OFF_KDT + (kd_ + i * 64) * 144 + kp_ * 16) = rK[i]; } \
        *(LAS u32x4*)(B_ + OFF_ATT + ar_ * 144 + ap_ * 16) = rA; \
        if (tid < 128) *(LAS u32x4*)(B_ + OFF_U + ur_ * 32 + up_ * 16) = rU; } while (0)
    SCAN_LOAD(0); SCAN_STORE(0);
    __syncthreads();
    f32x4 sacc = (f32x4){0.f, 0.f, 0.f, 0.f};
    for (int n = 0; n < 64; ++n) {
        LAS unsigned char* B_ = lds + (n & 1) * BUFSZ;
        if (n + 1 < 64) SCAN_LOAD(n + 1);
        const float eg = __expf(glarr[((b * 64 + n) * 4 + h) * 32]);
        const int ct = wave & 3;
        f32x4 acc = (f32x4){0.f, 0.f, 0.f, 0.f};
        { LAS unsigned char* X = B_ + (wave < 4 ? OFF_W : OFF_QD);
#pragma unroll
          for (int kk = 0; kk < 4; ++kk) {
              const bf16x8 a = *(const LAS bf16x8*)(X + (ct * 16 + fr) * 272 + (kk * 32 + fq * 8) * 2);
              const bf16x8 s = *(const LAS bf16x8*)(ST + fr * 272 + (kk * 32 + fq * 8) * 2);
              acc = __builtin_amdgcn_mfma_f32_16x16x32_bf16(a, s, acc, 0, 0, 0); } }
        if (wave < 4) {
            float vn[4];
#pragma unroll
            for (int j = 0; j < 4; ++j) vn[j] = bf2f(*(const LAS bf16_t*)(B_ + OFF_U + (ct * 16 + fq * 4 + j) * 32 + fr * 2)) - acc[j];
            u32x2 w; w.x = cvt_pk_bf16(vn[0], vn[1]); w.y = cvt_pk_bf16(vn[2], vn[3]);
            *(LAS u32x2*)(VNT + fr * 144 + (ct * 16 + fq * 4) * 2) = w;
        }
        __syncthreads();
        if (wave >= 4) {
#pragma unroll
            for (int kk = 0; kk < 2; ++kk) {
                const bf16x8 a = *(const LAS bf16x8*)(B_ + OFF_ATT + (ct * 16 + fr) * 144 + (kk * 32 + fq * 8) * 2);
                const bf16x8 v = *(const LAS bf16x8*)(VNT + fr * 144 + (kk * 32 + fq * 8) * 2);
                acc = __builtin_amdgcn_mfma_f32_16x16x32_bf16(a, v, acc, 0, 0, 0); }
#pragma unroll
            for (int j = 0; j < 4; ++j) obuf[((size_t)(bh * 8 + es) * 4096 + n * 64 + ct * 16 + fq * 4 + j) * 16 + fr] = f2bf(acc[j]);
        }
        sacc *= eg;
#pragma unroll
        for (int kk = 0; kk < 2; ++kk) {
            const bf16x8 a = *(const LAS bf16x8*)(B_ + OFF_KDT + (wave * 16 + fr) * 144 + (kk * 32 + fq * 8) * 2);
            const bf16x8 v = *(const LAS bf16x8*)(VNT + fr * 144 + (kk * 32 + fq * 8) * 2);
            sacc = __builtin_amdgcn_mfma_f32_16x16x32_bf16(a, v, sacc, 0, 0, 0); }
        { u32x2 w; w.x = cvt_pk_bf16(sacc[0], sacc[1]); w.y = cvt_pk_bf16(sacc[2], sacc[3]);
          *(LAS u32x2*)(ST + fr * 272 + (wave * 16 + fq * 4) * 2) = w; }
        if (n + 1 < 64) SCAN_STORE((n + 1) & 1);
        __syncthreads();
    }
#undef SCAN_LOAD
#undef SCAN_STORE
}

#define GRID_SYNC() do { asm volatile("s_waitcnt vmcnt(0) lgkmcnt(0)" ::: "memory"); grid.sync(); if (threadIdx.x < 64) { __builtin_amdgcn_fence(__ATOMIC_ACQUIRE, "agent"); asm volatile("s_waitcnt vmcnt(0)" ::: "memory"); } __syncthreads(); } while (0)
__global__ void __launch_bounds__(NTHR) fwd_megakernel(KParams P) {
    extern __shared__ __attribute__((aligned(16))) unsigned char lds_raw[];
    LAS unsigned char* lds = (LAS unsigned char*)lds_raw;
    cg::grid_group grid = cg::this_grid();
    const int G = gridDim.x, bid = blockIdx.x;
    unsigned char* ws = P.ws;
    const float* x_in = P.in[0];
    float* xio = P.out;

    if (P.lo <= 0 && 0 <= P.hi) {
    {
        const int tid = opaque_tid(), lane = tid & 63, wave = tid >> 6;
        LAS float* tile = (LAS float*)lds;
        convert_ffn_weights(tile, P.in[2], P.in[3], P.in[4], ws);
        { const float* w = P.in[7];
          transpose_job<2>(tile, 1024, 4608, 4616, (bf16_t*)(ws + WS_WINT), 1024, w, nullptr, 64); }
        { const float* w = P.in[12]; transpose_job<0>(tile, 512, 1024, 1024, (bf16_t*)(ws + WS_CATW), 1024, w, nullptr, 32); }
        { const float* w = P.in[16]; transpose_job<0>(tile, 1024, 1024, 1024, (bf16_t*)(ws + WS_WMIXT), 1024, w, nullptr, 160); }
        { const float* wk = P.in[22]; const float* wv = P.in[23];
          transpose_job<3>(tile, 1024, 2048, 1024, (bf16_t*)(ws + WS_WKVT), 1024, wk, wv, 96); }
        { const float* w = P.in[24]; transpose_job<0>(tile, 1024, 1024, 1024, (bf16_t*)(ws + WS_WOT), 1024, w, nullptr, 224); }
        {
            const float* w = P.in[21]; bf16_t* o = (bf16_t*)(ws + WS_WQ);
            for (int i = bid * NTHR + tid; i < 1024 * 1024 / 8; i += G * NTHR) { const f32x4 a = *(const f32x4*)(w + (size_t)i * 8), b = *(const f32x4*)(w + (size_t)i * 8 + 4);
                u32x4 q; q.x = cvt_pk_bf16(a[0], a[1]); q.y = cvt_pk_bf16(a[2], a[3]); q.z = cvt_pk_bf16(b[0], b[1]); q.w = cvt_pk_bf16(b[2], b[3]); *(u32x4*)(o + (size_t)i * 8) = q; }
        }
        {
            const float* pw = P.in[13]; const float* sc = P.in[14]; const float* wpb = P.in[15]; bf16_t* o = (bf16_t*)(ws + WS_CATW);
            for (int idx = bid * NTHR + tid; idx < 65536; idx += G * NTHR) {
                const int n = (idx >> 3) & 1023, oct = (idx >> 13) * 8 + (idx & 7), gg = oct >> 4, c0 = (oct & 15) * 8;
                float a[8];
#pragma unroll
                for (int i = 0; i < 8; ++i) a[i] = 0.f;
                for (int d = 0; d < 128; ++d) { const float wv = wpb[(size_t)(gg * 128 + d) * 1024 + n] * sc[gg * 128 + d];
#pragma unroll
                    for (int i = 0; i < 8; ++i) a[i] += pw[(gg * 128 + c0 + i) * 128 + d] * wv; }
                *(u32x4*)(o + (size_t)n * 1024 + 512 + gg * 128 + c0) = pack8(a);
            }
        }
        {
            bf16_t* xb = (bf16_t*)(ws + WS_A);
            for (size_t i = (size_t)bid * NTHR + tid; i < (size_t)MTOK * DM / 8; i += (size_t)G * NTHR) { const f32x4 a = *(const f32x4*)(x_in + i * 8), b = *(const f32x4*)(x_in + i * 8 + 4);
                u32x4 q; q.x = cvt_pk_bf16(a[0], a[1]); q.y = cvt_pk_bf16(a[2], a[3]); q.z = cvt_pk_bf16(b[0], b[1]); q.w = cvt_pk_bf16(b[2], b[3]); *(u32x4*)(xb + i * 8) = q; }
        }
        for (int row = bid * 8 + wave; row < 1024; row += G * 8) { f32x4 y[4]; ln_row(P.in[1] + (size_t)row * DM, P.in[19], P.in[20], lane, y); store_row_bf16((bf16_t*)(ws + WS_MB) + (size_t)row * DM, lane, y); }
    }
    }
    if (P.lo <= 0 && 0 < P.hi) GRID_SYNC();

    if (P.lo <= 1 && 1 <= P.hi) {
    {
        DescPlain g{(const bf16_t*)(ws + WS_A), (const bf16_t*)(ws + WS_FFNGU), 1024, 1024, 1024, 30, 0};
        pg8::StaticOrder S; S.init(64, 22, G, bid); EpiSwiglu E{(bf16_t*)(ws + WS_H)};
        pg8::gemm_phase(lds, g, S, E);
        DescPlain g2{(const bf16_t*)(ws + WS_MB), (const bf16_t*)(ws + WS_WKVT), 1024, 1024, 1024, 30, 0};
        pg8::StaticOrder S2; S2.init(4, 8, G, G - 1 - bid); EpiKV E2{(bf16_t*)(ws + WS_KV)};
        pg8::gemm_phase(lds, g2, S2, E2);
    }
    }
    if (P.lo <= 1 && 1 < P.hi) GRID_SYNC();

    if (P.lo <= 2 && 2 <= P.hi) {
    {
        DescPlain g{(const bf16_t*)(ws + WS_H), (const bf16_t*)(ws + WS_FFND), FF, FF, FF, 30, 0};
        pg8::StaticOrder S; S.init(64, 4, G, bid); EpiResF32 E{x_in, xio, 0.5f};
        pg8::gemm_phase(lds, g, S, E);
    }
    }
    if (P.lo <= 2 && 2 < P.hi) GRID_SYNC();

    if (P.lo <= 3 && 3 <= P.hi) {
    {
        const int tid = opaque_tid(), lane = tid & 63, wave = tid >> 6;
        LAS float* wab = (LAS float*)lds;
        for (int i = tid; i < 8192; i += NTHR) wab[i] = P.in[7][(size_t)(i & 1023) * 4616 + 2048 + (i >> 10)];
        __syncthreads();
        bf16_t* xb = (bf16_t*)(ws + WS_A); float* garr = (float*)(ws + WS_GARR); float* betaarr = (float*)(ws + WS_BETA);
        for (int row = bid * 8 + wave; row < MTOK; row += G * 8) {
            f32x4 y[4]; ln_row(xio + (size_t)row * DM, P.in[5], P.in[6], lane, y);
#pragma unroll
            for (int j = 0; j < 4; ++j) *(f32x4*)(xio + (size_t)row * DM + j * 256 + lane * 4) = y[j];
            store_row_bf16(xb + (size_t)row * DM, lane, y);
            float s[8];
#pragma unroll
            for (int c = 0; c < 8; ++c) { float a = 0.f;
#pragma unroll
                for (int j = 0; j < 4; ++j) { const f32x4 wv = *(const LAS f32x4*)(wab + c * 1024 + j * 256 + lane * 4); a += (y[j][0] * wv[0] + y[j][1] * wv[1]) + (y[j][2] * wv[2] + y[j][3] * wv[3]); }
                s[c] = wave_sum(a); }
            if (lane < 4) {
                const float av = lane == 0 ? s[0] : lane == 1 ? s[1] : lane == 2 ? s[2] : s[3];
                const float bv = lane == 0 ? s[4] : lane == 1 ? s[5] : lane == 2 ? s[6] : s[7];
                const float xx = av + P.in[10][lane];
                const float sp = fmaxf(xx, 0.f) + log1pf(__expf(-fabsf(xx)));
                garr[(size_t)row * 4 + lane] = -__expf(P.in[9][lane]) * sp;
                betaarr[(size_t)row * 4 + lane] = 1.0f / (1.0f + __expf(-bv));
            }
        }
    }
    }
    if (P.lo <= 3 && 3 < P.hi) GRID_SYNC();

    if (P.lo <= 4 && 4 <= P.hi) {
    {
        DescPlain g{(const bf16_t*)(ws + WS_A), (const bf16_t*)(ws + WS_WINT), 1024, 1024, 1024, 30, 0};
        pg8::StaticOrder S; S.init(64, 18, G, bid); EpiWin E{ws};
        pg8::gemm_phase(lds, g, S, E);
        DescKQ g2{(const bf16_t*)(ws + WS_KV), (const bf16_t*)(ws + WS_WQ), 256, 2048, 1024};
        pg8::StaticOrder S2; S2.init(16, 4, G, G - 1 - bid); EpiKQ E2{(bf16_t*)(ws + WS_KQT)};
        pg8::gemm_phase(lds, g2, S2, E2);
        DescVWo g3{(const bf16_t*)(ws + WS_WOT), (const bf16_t*)(ws + WS_KV), 256, 1024, 2048};
        pg8::StaticOrder S3; S3.init(4, 16, G, G - 1 - bid - 64); EpiVWo E3{(bf16_t*)(ws + WS_VWOT)};
        pg8::gemm_phase(lds, g3, S3, E3);
    }
    }
    if (P.lo <= 4 && 4 < P.hi) GRID_SYNC();

    if (P.lo <= 5 && 5 <= P.hi) {
    {
        const int tid = opaque_tid();
        const bf16_t* pp = (const bf16_t*)(ws + WS_PP); bf16_t* cat = (bf16_t*)(ws + WS_A);
        for (int ch = bid; ch < 256; ch += G) {
            const int c = tid, win = 2 << (c >> 7), pos0 = (ch & 63) * 64; const size_t row0 = (size_t)ch * 64;
            float s = 0.f;
            for (int t = -(win - 1); t < 0; ++t) if (pos0 + t >= 0) s += bf2f(pp[(row0 + t) * 512 + c]);
            for (int t = 0; t < 64; ++t) {
                const float pv = bf2f(pp[(row0 + t) * 512 + c]); s += pv;
                const int pos = pos0 + t; const float cnt = (float)(pos + 1 < win ? pos + 1 : win);
                cat[(row0 + t) * 1024 + 512 + c] = f2bf(s / cnt - pv);
                if (pos - win + 1 >= 0) s -= bf2f(pp[(row0 + t - win + 1) * 512 + c]);
            }
        }
        for (int unit = bid; unit < 1024; unit += G) dn_prep_unit(P, lds, unit);
    }
    }
    if (P.lo <= 5 && 5 < P.hi) GRID_SYNC();

    if (P.lo <= 6 && 6 <= P.hi) {
    dn_scan(P, lds);
    }
    if (P.lo <= 6 && 6 < P.hi) GRID_SYNC();

    if (P.lo <= 7 && 7 <= P.hi) {
    {
        const int tid = opaque_tid(), lane = tid & 63, wave = tid >> 6;
        const bf16_t* ob = (const bf16_t*)(ws + WS_O); const bf16_t* zb = (const bf16_t*)(ws + WS_ZB); bf16_t* cat = (bf16_t*)(ws + WS_A);
        const float* nw = P.in[11] + (lane & 15) * 8;
        const f32x4 nw0 = *(const f32x4*)nw, nw1 = *(const f32x4*)(nw + 4);
        for (int row = bid * 8 + wave; row < MTOK; row += G * 8) {
            float o[8], z[8]; unpack8(*(const u32x4*)(ob + ((size_t)(((row >> 12) * 4 + (lane >> 4)) * 8 + ((lane & 15) >> 1)) * 4096 + (row & 4095)) * 16 + (lane & 1) * 8), o); unpack8(*(const u32x4*)(zb + (size_t)row * 512 + lane * 8), z);
            float ss = 0.f;
#pragma unroll
            for (int i = 0; i < 8; ++i) ss += o[i] * o[i];
            ss += __shfl_xor(ss, 1); ss += __shfl_xor(ss, 2); ss += __shfl_xor(ss, 4); ss += __shfl_xor(ss, 8);
            const float rs = 1.0f / sqrtf(ss * (1.0f / 128.0f) + 1e-6f);
            float v[8];
#pragma unroll
            for (int i = 0; i < 8; ++i) v[i] = o[i] * rs * (i < 4 ? nw0[i & 3] : nw1[i & 3]) * siluf_(z[i]);
            *(u32x4*)(cat + (size_t)row * 1024 + lane * 8) = pack8(v);
        }
    }
    }
    if (P.lo <= 7 && 7 < P.hi) GRID_SYNC();

    if (P.lo <= 8 && 8 <= P.hi) {
    {
        DescPlain g{(const bf16_t*)(ws + WS_A), (const bf16_t*)(ws + WS_CATW), 1024, 1024, 1024, 30, 0};
        pg8::StaticOrder S; S.init(64, 4, G, bid); EpiMerge E{(const bf16_t*)(ws + WS_G), (const bf16_t*)(ws + WS_G + 32 * MiB), (bf16_t*)(ws + WS_MERGED)};
        pg8::gemm_phase(lds, g, S, E);
    }
    }
    if (P.lo <= 8 && 8 < P.hi) GRID_SYNC();

    if (P.lo <= 9 && 9 <= P.hi) {
    {
        DescPlain g{(const bf16_t*)(ws + WS_MERGED), (const bf16_t*)(ws + WS_WMIXT), 1024, 1024, 1024, 30, 0};
        pg8::StaticOrder S; S.init(64, 4, G, bid); EpiResF32 E{xio, xio, 1.0f};
        pg8::gemm_phase(lds, g, S, E);
    }
    }
    if (P.lo <= 9 && 9 < P.hi) GRID_SYNC();

    if (P.lo <= 10 && 10 <= P.hi) {
    ln_phase(xio, (bf16_t*)(ws + WS_A), P.in[17], P.in[18]);
    __syncthreads();
    convert_ffn_weights((LAS float*)lds, P.in[27], P.in[28], P.in[29], ws);
    }
    if (P.lo <= 10 && 10 < P.hi) GRID_SYNC();

    if (P.lo <= 11 && 11 <= P.hi) {
    {
        DescPlain g{(const bf16_t*)(ws + WS_A), (const bf16_t*)(ws + WS_KQT), 1024, 1024, 1024, 4, (size_t)1024 * 1024};
        pg8::StaticOrder S; S.init(64, 4, G, bid); EpiSoftmax E{(bf16_t*)(ws + WS_PB)};
        pg8::gemm_phase(lds, g, S, E);
    }
    }
    if (P.lo <= 11 && 11 < P.hi) GRID_SYNC();

    if (P.lo <= 12 && 12 <= P.hi) {
    {
        DescPlain g{(const bf16_t*)(ws + WS_PB), (const bf16_t*)(ws + WS_VWOT), 1024, 1024, 1024, 4, (size_t)1024 * 1024};
        pg8::StaticOrder S; S.init(64, 4, G, bid); EpiResF32 E{xio, xio, 1.0f};
        pg8::gemm_phase(lds, g, S, E);
    }
    }
    if (P.lo <= 12 && 12 < P.hi) GRID_SYNC();

    if (P.lo <= 13 && 13 <= P.hi) {
    ln_phase(xio, (bf16_t*)(ws + WS_A), P.in[25], P.in[26]);
    }
    if (P.lo <= 13 && 13 < P.hi) GRID_SYNC();

    if (P.lo <= 14 && 14 <= P.hi) {
    {
        DescPlain g{(const bf16_t*)(ws + WS_A), (const bf16_t*)(ws + WS_FFNGU), 1024, 1024, 1024, 30, 0};
        pg8::StaticOrder S; S.init(64, 22, G, bid); EpiSwiglu E{(bf16_t*)(ws + WS_H)};
        pg8::gemm_phase(lds, g, S, E);
    }
    }
    if (P.lo <= 14 && 14 < P.hi) GRID_SYNC();

    if (P.lo <= 15 && 15 <= P.hi) {
    {
        DescPlain g{(const bf16_t*)(ws + WS_H), (const bf16_t*)(ws + WS_FFND), FF, FF, FF, 30, 0};
        pg8::StaticOrder S; S.init(64, 4, G, bid); EpiResF32 E{xio, xio, 0.5f};
        pg8::gemm_phase(lds, g, S, E);
    }
    }
    if (P.lo <= 15 && 15 < P.hi) GRID_SYNC();

    if (P.lo <= 16 && 16 <= P.hi) {
    ln_phase(xio, nullptr, P.in[30], P.in[31]);
    }
}

extern "C" void kernel_launch(void* const* d_in, const int* in_sizes, int n_in, void* d_out, int out_size, void* d_ws, size_t ws_size, hipStream_t stream) {
    static int grid_blocks = 0;
    if (!grid_blocks) {
        int dev = 0, cus = 0, per_cu = 0;
        hipGetDevice(&dev);
        hipDeviceGetAttribute(&cus, hipDeviceAttributeMultiprocessorCount, dev);
        if (hipFuncSetAttribute((const void*)fwd_megakernel, hipFuncAttributeMaxDynamicSharedMemorySize, LDS_BYTES) != hipSuccess) fprintf(stderr, "kernel_launch: hipFuncSetAttribute failed\n");
        if (hipOccupancyMaxActiveBlocksPerMultiprocessor(&per_cu, (const void*)fwd_megakernel, NTHR, LDS_BYTES) != hipSuccess || per_cu < 1) { fprintf(stderr, "kernel_launch: occupancy query gave %d\n", per_cu); per_cu = 1; }
        (void)hipGetLastError();
        grid_blocks = cus * per_cu;
        if (ws_size < WS_END) fprintf(stderr, "kernel_launch: workspace too small: %zu < %zu\n", ws_size, (size_t)WS_END);
    }
    KParams p{};
    for (int i = 0; i < 32; ++i) p.in[i] = (const float*)d_in[i];
    p.out = (float*)d_out; p.ws = (unsigned char*)d_ws;
    void* args[] = {&p};
    hipError_t e = hipSuccess;
#if PER_PHASE_LAUNCH
    for (int ph = 0; ph < 17 && e == hipSuccess; ++ph) { p.lo = ph; p.hi = ph;
        e = hipLaunchCooperativeKernel((const void*)fwd_megakernel, dim3(grid_blocks), dim3(NTHR), args, LDS_BYTES, stream); }
#else
    p.lo = 0; p.hi = 16;
    e = hipLaunchCooperativeKernel((const void*)fwd_megakernel, dim3(grid_blocks), dim3(NTHR), args, LDS_BYTES, stream);
#endif
    if (e != hipSuccess) fprintf(stderr, "cooperative launch failed: %s (grid %d)\n", hipGetErrorString(e), grid_blocks);
}
```

```cpp
#include <hip/hip_runtime.h>
#include <hip/hip_cooperative_groups.h>
#include <cstdio>
namespace cg = cooperative_groups;
#ifndef PER_PHASE_LAUNCH
#define PER_PHASE_LAUNCH 0
#endif

#define LAS __attribute__((address_space(3)))
typedef unsigned short bf16_t;
typedef short bf16x8 __attribute__((ext_vector_type(8)));
typedef float f32x4 __attribute__((ext_vector_type(4)));
typedef float f32x2 __attribute__((ext_vector_type(2)));
typedef unsigned u32x4 __attribute__((ext_vector_type(4)));
typedef unsigned u32x2 __attribute__((ext_vector_type(2)));

constexpr int MTOK = 16384, DM = 1024, FF = 2816, NTHR = 512;
constexpr int LDS_BYTES = 147456;
constexpr float ALPHA = 1.189207115002721f;

constexpr size_t MiB = 1u << 20;
constexpr size_t WS_FFNGU = 0;
constexpr size_t WS_FFND  = 11 * MiB;
constexpr size_t WS_WINT  = 16 * MiB + MiB / 2;
constexpr size_t WS_CATW  = WS_WINT + 9 * MiB;
constexpr size_t WS_WMIXT = WS_CATW + 2 * MiB;
constexpr size_t WS_WQ    = WS_WMIXT + 2 * MiB;
constexpr size_t WS_WKVT  = WS_WQ + 2 * MiB;
constexpr size_t WS_WOT   = WS_WKVT + 4 * MiB;
constexpr size_t WS_MB    = WS_WOT + 2 * MiB;
constexpr size_t WS_KV    = WS_MB + 2 * MiB;
constexpr size_t WS_KQT   = WS_KV + 4 * MiB;
constexpr size_t WS_VWOT  = WS_KQT + 8 * MiB;
constexpr size_t WS_SMALL = WS_VWOT + 8 * MiB;
constexpr size_t WS_HALO  = WS_SMALL + 1 * MiB;
constexpr size_t WS_A     = WS_HALO + 2 * MiB + MiB / 2;
constexpr size_t WS_H     = WS_A + 32 * MiB;
constexpr size_t WS_G     = WS_H + 88 * MiB;
constexpr size_t WS_END   = WS_G + 64 * MiB;
constexpr size_t WS_QKVB = WS_H, WS_ZB = WS_H + 48 * MiB, WS_PP = WS_H + 64 * MiB, WS_ATT = WS_H + 80 * MiB;
constexpr size_t WS_O = WS_PP, WS_MERGED = WS_H, WS_PB = WS_H, WS_WBUF = WS_FFNGU;
constexpr size_t WS_GARR = WS_SMALL, WS_BETA = WS_SMALL + 256 * 1024, WS_GL = WS_SMALL + 512 * 1024;

struct KParams { const float* in[32]; float* out; unsigned char* ws; int lo, hi; };

__device__ __forceinline__ int opaque_tid() { int t = threadIdx.x; asm volatile("" : "+v"(t)); return t; }
typedef __bf16 bf16x2_t __attribute__((ext_vector_type(2)));
__device__ __forceinline__ unsigned cvt_pk_bf16(float lo, float hi) { const f32x2 v = {lo, hi}; return __builtin_bit_cast(unsigned, __builtin_convertvector(v, bf16x2_t)); }
__device__ __forceinline__ bf16_t f2bf(float f) { return (bf16_t)(cvt_pk_bf16(f, 0.f) & 0xffffu); }
__device__ __forceinline__ float bf_lo(unsigned w) { return __uint_as_float(w << 16); }
__device__ __forceinline__ float bf_hi(unsigned w) { return __uint_as_float(w & 0xffff0000u); }
__device__ __forceinline__ float bf2f(bf16_t b) { return __uint_as_float(((unsigned)b) << 16); }
__device__ __forceinline__ float sigmoidf_(float x) { return __builtin_amdgcn_rcpf(1.0f + __expf(-x)); }
__device__ __forceinline__ float siluf_(float x) { return x * __builtin_amdgcn_rcpf(1.0f + __expf(-x)); }
__device__ __forceinline__ float wave_sum(float v) { v += __shfl_xor(v, 32); v += __shfl_xor(v, 16); v += __shfl_xor(v, 8); v += __shfl_xor(v, 4); v += __shfl_xor(v, 2); v += __shfl_xor(v, 1); return v; }
__device__ __forceinline__ void unpack8(const u32x4 w, float (&f)[8]) { f[0] = bf_lo(w.x); f[1] = bf_hi(w.x); f[2] = bf_lo(w.y); f[3] = bf_hi(w.y); f[4] = bf_lo(w.z); f[5] = bf_hi(w.z); f[6] = bf_lo(w.w); f[7] = bf_hi(w.w); }
__device__ __forceinline__ u32x4 pack8(const float (&f)[8]) { u32x4 w; w.x = cvt_pk_bf16(f[0], f[1]); w.y = cvt_pk_bf16(f[2], f[3]); w.z = cvt_pk_bf16(f[4], f[5]); w.w = cvt_pk_bf16(f[6], f[7]); return w; }

namespace pg8 {
constexpr int BM = 256, BK = 64, HALF = 128, HTB = HALF * BK * 2, STAGE_BYTES = 8 * HTB, NXCD = 8, WGM = 8;
__device__ __forceinline__ int lds_byte(int r, int c) { const int st = (r >> 4) * 2 + (c >> 5), rr = r & 15, cc = c & 31, ob = rr * 64 + cc * 2; return st * 1024 + (ob ^ (((ob >> 9) & 1) << 5)); }
__device__ __forceinline__ void stage_rc(int b, int& R, int& C) { const int st = b / 1024, sb = b % 1024, swz = sb ^ (((sb >> 9) & 1) << 5); R = (st >> 1) * 16 + swz / 64; C = (st & 1) * 32 + (swz % 64) / 2; }
__device__ __forceinline__ int perm32(int rho) { const int n = rho >> 4, i = rho & 15; return 8 * (i >> 2) + 4 * n + (i & 3); }
struct Unit { int pm, pn; };
struct StaticOrder {
    int nM, nN, nwg, G, c;
    __device__ void init(int nM_, int nN_, int G_, int c_) { nM = nM_; nN = nN_; nwg = nM * nN; G = G_; c = c_; }
    __device__ bool next(int i, Unit& u) const {
        if (c < 0) return false;
        const long L = (long)i * G + c; if (L >= nwg) return false;
        int wgid = (int)L; { const int q = nwg / NXCD, r = nwg % NXCD, xcd = wgid % NXCD, off = wgid / NXCD; wgid = (xcd < r ? xcd * (q + 1) : r * (q + 1) + (xcd - r) * q) + off; }
        const int nig = WGM * nN, gid = wgid / nig, fm = gid * WGM, gsz = (nM - fm) < WGM ? (nM - fm) : WGM;
        u.pm = fm + ((wgid % nig) % gsz); u.pn = (wgid % nig) / gsz; return true;
    }
};
template <class Desc, class Epi, class Sched>
__device__ __forceinline__ void gemm_phase(LAS unsigned char* lds, const Desc& g, const Sched& S, const Epi& E) {
    const int tid = opaque_tid(), wid = __builtin_amdgcn_readfirstlane(tid >> 6), lane = tid & 63, wr = wid >> 2, wc = wid & 3, fr = lane & 15, fq = lane >> 4;
    const int K = g.K, nt = K / BK;
    unsigned voffA[2], voffB[2];
#pragma unroll
    for (int i = 0; i < 2; ++i) { int R, C; stage_rc(tid * 16 + i * 8192, R, C); const int Rb = Epi::PERM ? ((R & ~31) + perm32(R & 31)) : R;
        voffA[i] = (unsigned)(R * g.lda + C) * 2u; voffB[i] = (unsigned)(Rb * g.ldb + C) * 2u; }
    const size_t kstep = (size_t)(BK * 2);
    const size_t hstepA = (size_t)HALF * g.lda * 2, hstepB = (size_t)HALF * g.ldb * 2;
    const unsigned ldsw = (unsigned)wid * 1024u;
    const int aoff = lds_byte(wr * 64 + fr, fq * 8), boff = lds_byte(wc * 32 + fr, fq * 8);
#define PG8_SA(b, h) (((b) * 2 + (h)) * HTB)
#define PG8_SB(b, h) ((4 + (b) * 2 + (h)) * HTB)
#define PG8_STAGE(bufoff, gbase, voff) do { _Pragma("unroll") for (int _i = 0; _i < 2; ++_i) \
        __builtin_amdgcn_global_load_lds((const unsigned*)((const char*)(gbase) + (voff)[_i]), (LAS unsigned*)(lds + (bufoff) + ldsw + _i * 8192), 16, 0, 0); } while (0)
#define PG8_LDA(dst, b, h) do { _Pragma("unroll") for (int m = 0; m < 4; ++m) _Pragma("unroll") for (int k = 0; k < 2; ++k) dst[m][k] = *(const LAS bf16x8*)(lds + PG8_SA(b, h) + aoff + m * 2048 + k * 1024); } while (0)
#define PG8_LDB(dst, b, h) do { _Pragma("unroll") for (int n = 0; n < 2; ++n) _Pragma("unroll") for (int k = 0; k < 2; ++k) dst[n][k] = *(const LAS bf16x8*)(lds + PG8_SB(b, h) + boff + n * 2048 + k * 1024); } while (0)
#define PG8_MMA(ai, bj, At, Bt) do { __builtin_amdgcn_s_setprio(1); _Pragma("unroll") for (int m = 0; m < 4; ++m) _Pragma("unroll") for (int n = 0; n < 2; ++n) _Pragma("unroll") for (int k = 0; k < 2; ++k) \
        acc[ai][bj][m][n] = __builtin_amdgcn_mfma_f32_16x16x32_bf16(Bt[n][k], At[m][k], acc[ai][bj][m][n], 0, 0, 0); __builtin_amdgcn_s_setprio(0); } while (0)
#define PG8_WAIT_V(n) asm volatile("s_waitcnt vmcnt(" #n ")" ::: "memory")
#define PG8_WAIT_L(n) asm volatile("s_waitcnt lgkmcnt(" #n ")" ::: "memory")
#define PG8_BAR __builtin_amdgcn_s_barrier()
#define PG8_SCHED __builtin_amdgcn_sched_barrier(0)
    Unit cur, nxt; int ui = 0;
    if (!S.next(0, cur)) return;
    f32x4 acc[2][2][4][2];
#pragma unroll
    for (int a = 0; a < 2; ++a)
#pragma unroll
        for (int b = 0; b < 2; ++b)
#pragma unroll
            for (int m = 0; m < 4; ++m)
#pragma unroll
                for (int n = 0; n < 2; ++n) acc[a][b][m][n] = (f32x4){0.f, 0.f, 0.f, 0.f};
    bf16x8 At[4][2], B0[2][2], B1[2][2];
    const char* cA = g.abase(cur); const char* cB = g.bbase(cur);
    PG8_STAGE(PG8_SB(0, 0), cB, voffB); PG8_STAGE(PG8_SA(0, 0), cA, voffA); PG8_STAGE(PG8_SB(0, 1), cB + hstepB, voffB); PG8_STAGE(PG8_SA(0, 1), cA + hstepA, voffA);
    if (wr == 1) PG8_BAR;
    PG8_WAIT_V(4); PG8_BAR;
    PG8_STAGE(PG8_SB(1, 0), cB + kstep, voffB); PG8_STAGE(PG8_SA(1, 0), cA + kstep, voffA); PG8_STAGE(PG8_SB(1, 1), cB + hstepB + kstep, voffB);
    PG8_WAIT_V(6); PG8_BAR;
    for (;;) {
        const bool has_next = S.next(ui + 1, nxt);
        const char* nA = has_next ? g.abase(nxt) : cA; const char* nB = has_next ? g.bbase(nxt) : cB;
        for (int t = 0; t < nt; t += 2) {
            const bool last = (t == nt - 2);
            const char* a1 = cA + (size_t)(t + 1) * kstep;
            const char* a2 = last ? nA : cA + (size_t)(t + 2) * kstep; const char* b2 = last ? nB : cB + (size_t)(t + 2) * kstep;
            const char* a3 = a2 + kstep; const char* b3 = b2 + kstep;
            if constexpr (Epi::HAS_MID) { if (t == nt / 2) E.mid(acc, cur, wr, wc, fr, fq); }
            PG8_LDB(B0, 0, 0); PG8_SCHED; PG8_LDA(At, 0, 0); PG8_STAGE(PG8_SA(1, 1), a1 + hstepA, voffA);
            PG8_WAIT_L(8); PG8_BAR; PG8_WAIT_L(0); PG8_MMA(0, 0, At, B0); PG8_BAR; PG8_SCHED;
            PG8_LDB(B1, 0, 1); PG8_STAGE(PG8_SB(0, 0), b2, voffB);
            PG8_BAR; PG8_WAIT_L(0); PG8_MMA(0, 1, At, B1); PG8_BAR;
            PG8_LDA(At, 0, 1); PG8_STAGE(PG8_SA(0, 0), a2, voffA);
            PG8_BAR; PG8_WAIT_L(0); PG8_MMA(1, 0, At, B0); PG8_BAR; PG8_SCHED;
            PG8_STAGE(PG8_SB(0, 1), b2 + hstepB, voffB);
            PG8_WAIT_V(6); PG8_BAR; PG8_MMA(1, 1, At, B1); PG8_BAR;
            PG8_LDB(B0, 1, 0); PG8_SCHED; PG8_LDA(At, 1, 0); PG8_STAGE(PG8_SA(0, 1), a2 + hstepA, voffA);
            PG8_WAIT_L(8); PG8_BAR; PG8_WAIT_L(0); PG8_MMA(0, 0, At, B0); PG8_BAR; PG8_SCHED;
            PG8_LDB(B1, 1, 1); PG8_STAGE(PG8_SB(1, 0), b3, voffB);
            PG8_BAR; PG8_WAIT_L(0); PG8_MMA(0, 1, At, B1); PG8_BAR;
            PG8_LDA(At, 1, 1); PG8_STAGE(PG8_SA(1, 0), a3, voffA);
            PG8_BAR; PG8_WAIT_L(0); PG8_MMA(1, 0, At, B0); PG8_BAR; PG8_SCHED;
            PG8_STAGE(PG8_SB(1, 1), b3 + hstepB, voffB);
            PG8_WAIT_V(6); PG8_BAR; PG8_MMA(1, 1, At, B1); PG8_BAR;
        }
        if constexpr (!Epi::AFTER_DRAIN) { E(acc, cur, wr, wc, fr, fq); }
        if (!has_next) break;
#pragma unroll
        for (int a = 0; a < 2; ++a)
#pragma unroll
            for (int b = 0; b < 2; ++b)
#pragma unroll
                for (int m = 0; m < 4; ++m)
#pragma unroll
                    for (int n = 0; n < 2; ++n) acc[a][b][m][n] = (f32x4){0.f, 0.f, 0.f, 0.f};
        cur = nxt; cA = nA; cB = nB; ++ui;
    }
    PG8_WAIT_V(0);
    if (wr == 0) PG8_BAR;
    PG8_BAR;
    if constexpr (Epi::AFTER_DRAIN) { E.fused(acc, cur, wr, wc, fr, fq, lds, wid, lane); }
#undef PG8_SA
#undef PG8_SB
#undef PG8_STAGE
#undef PG8_LDA
#undef PG8_LDB
#undef PG8_MMA
#undef PG8_WAIT_V
#undef PG8_WAIT_L
#undef PG8_BAR
#undef PG8_SCHED
}
}
using pg8::Unit;
typedef f32x4 AccT[2][2][4][2];

struct DescPlain {
    const bf16_t* A; const bf16_t* Bt; int K, lda, ldb; int bshift; size_t bstride;
    __device__ __forceinline__ const char* abase(const Unit& u) const { return (const char*)(A + (size_t)u.pm * 256 * lda); }
    __device__ __forceinline__ const char* bbase(const Unit& u) const { return (const char*)(Bt + (size_t)u.pn * 256 * ldb + (size_t)(u.pm >> bshift) * bstride); }
};
struct DescKQ {
    const bf16_t* KV; const bf16_t* Wq; int K, lda, ldb;
    __device__ __forceinline__ const char* abase(const Unit& u) const { return (const char*)(KV + (size_t)(u.pm >> 2) * 256 * 2048 + (u.pm & 3) * 256); }
    __device__ __forceinline__ const char* bbase(const Unit& u) const { return (const char*)(Wq + (size_t)u.pn * 256 * 1024 + (u.pm & 3) * 256); }
};
struct DescVWo {
    const bf16_t* WoT; const bf16_t* KV; int K, lda, ldb;
    __device__ __forceinline__ const char* abase(const Unit& u) const { return (const char*)(WoT + (size_t)u.pm * 256 * 1024 + (u.pn & 3) * 256); }
    __device__ __forceinline__ const char* bbase(const Unit& u) const { return (const char*)(KV + (size_t)(u.pn >> 2) * 256 * 2048 + 1024 + (u.pn & 3) * 256); }
};

__device__ __forceinline__ void store_tile_bf16(const AccT& acc, bf16_t* tile00, int ldc, float scale, bool sig, int wr, int wc, int fr, int fq) {
    bf16_t* p0 = tile00 + (size_t)(wr * 64 + fr) * ldc + wc * 32 + 8 * fq;
#pragma unroll
    for (int ai = 0; ai < 2; ++ai)
#pragma unroll
        for (int m = 0; m < 4; ++m) { bf16_t* rowp = p0 + (size_t)(ai * 128 + m * 16) * ldc;
#pragma unroll
            for (int bj = 0; bj < 2; ++bj) { f32x4 v0 = acc[ai][bj][m][0] * scale, v1 = acc[ai][bj][m][1] * scale;
                if (sig) {
#pragma unroll
                    for (int j = 0; j < 4; ++j) { v0[j] = sigmoidf_(v0[j]); v1[j] = sigmoidf_(v1[j]); } }
                u32x4 w; w.x = cvt_pk_bf16(v0[0], v0[1]); w.y = cvt_pk_bf16(v0[2], v0[3]); w.z = cvt_pk_bf16(v1[0], v1[1]); w.w = cvt_pk_bf16(v1[2], v1[3]);
                *(u32x4*)(rowp + bj * 128) = w; }
            asm volatile("" ::: "memory"); }
}
struct EpiSwiglu {
    static constexpr bool PERM = false, AFTER_DRAIN = false, HAS_MID = false;
    bf16_t* H;
    __device__ __forceinline__ void operator()(const AccT& acc, const Unit& u, int wr, int wc, int fr, int fq) const {
        const int row0 = u.pm * 256 + wr * 64 + fr, col0 = u.pn * 128 + wc * 16 + 4 * fq;
#pragma unroll
        for (int ai = 0; ai < 2; ++ai)
#pragma unroll
            for (int m = 0; m < 4; ++m) { bf16_t* rowp = H + (size_t)(row0 + ai * 128 + m * 16) * FF + col0;
#pragma unroll
                for (int bj = 0; bj < 2; ++bj) { const f32x4 gt = acc[ai][bj][m][0], up = acc[ai][bj][m][1]; f32x4 h;
#pragma unroll
                    for (int j = 0; j < 4; ++j) h[j] = siluf_(gt[j]) * up[j];
                    u32x2 w; w.x = cvt_pk_bf16(h[0], h[1]); w.y = cvt_pk_bf16(h[2], h[3]); *(u32x2*)(rowp + bj * 64) = w; } }
    }
};
struct EpiResF32 {
    static constexpr bool PERM = false, AFTER_DRAIN = false, HAS_MID = false;
    const float* res; float* out; float scale;
    __device__ __forceinline__ void operator()(const AccT& acc, const Unit& u, int wr, int wc, int fr, int fq) const {
        const int row0 = u.pm * 256 + wr * 64 + fr, col0 = u.pn * 256 + wc * 32 + 4 * fq;
#pragma unroll
        for (int ai = 0; ai < 2; ++ai)
#pragma unroll
            for (int m = 0; m < 4; ++m) { const size_t off = (size_t)(row0 + ai * 128 + m * 16) * DM + col0;
                f32x4 r[2][2];
#pragma unroll
                for (int bj = 0; bj < 2; ++bj)
#pragma unroll
                    for (int n = 0; n < 2; ++n) r[bj][n] = *(const f32x4*)(res + off + bj * 128 + n * 16);
#pragma unroll
                for (int bj = 0; bj < 2; ++bj)
#pragma unroll
                    for (int n = 0; n < 2; ++n) *(f32x4*)(out + off + bj * 128 + n * 16) = r[bj][n] * ALPHA + acc[ai][bj][m][n] * scale;
                asm volatile("" ::: "memory"); }
    }
};
struct EpiWin {
    static constexpr bool PERM = true, AFTER_DRAIN = false, HAS_MID = false;
    unsigned char* ws;
    __device__ __forceinline__ void operator()(const AccT& acc, const Unit& u, int wr, int wc, int fr, int fq) const {
        const int pn = u.pn; const size_t r0 = (size_t)u.pm * 256;
        size_t boff; int ldc, ct;
        if (pn < 6) { boff = WS_QKVB; ldc = 1536; ct = pn; }
        else if (pn < 8) { boff = WS_ZB; ldc = 512; ct = pn - 6; }
        else if (pn < 10) { boff = WS_PP; ldc = 512; ct = pn - 8; }
        else if (pn < 14) { boff = WS_G; ldc = 1024; ct = pn - 10; }
        else { boff = WS_G + 32 * MiB; ldc = 1024; ct = pn - 14; }
        store_tile_bf16(acc, (bf16_t*)(ws + boff) + r0 * ldc + ct * 256, ldc, 1.f, pn >= 10, wr, wc, fr, fq);
        if (pn < 6 && fr >= 13) {
            bf16_t* halo = (bf16_t*)(ws + WS_HALO);
#pragma unroll
            for (int ai = 0; ai < 2; ++ai) { const int row = u.pm * 256 + ai * 128 + wr * 64 + 48 + fr;
                bf16_t* rowp = halo + (size_t)((row >> 6) * 3 + (row & 63) - 61) * 1536 + pn * 256 + wc * 32 + 8 * fq;
#pragma unroll
                for (int bj = 0; bj < 2; ++bj) { const f32x4 v0 = acc[ai][bj][3][0], v1 = acc[ai][bj][3][1];
                    u32x4 w; w.x = cvt_pk_bf16(v0[0], v0[1]); w.y = cvt_pk_bf16(v0[2], v0[3]); w.z = cvt_pk_bf16(v1[0], v1[1]); w.w = cvt_pk_bf16(v1[2], v1[3]);
                    *(u32x4*)(rowp + bj * 128) = w; } }
        }
    }
};
struct EpiKV {
    static constexpr bool PERM = true, AFTER_DRAIN = false, HAS_MID = false;
    bf16_t* KV;
    __device__ __forceinline__ void operator()(const AccT& acc, const Unit& u, int wr, int wc, int fr, int fq) const {
        store_tile_bf16(acc, KV + (size_t)u.pm * 256 * 2048 + u.pn * 256, 2048, 1.f, false, wr, wc, fr, fq); }
};
struct EpiKQ {
    static constexpr bool PERM = true, AFTER_DRAIN = false, HAS_MID = false;
    bf16_t* KQT;
    __device__ __forceinline__ void operator()(const AccT& acc, const Unit& u, int wr, int wc, int fr, int fq) const {
        store_tile_bf16(acc, KQT + (size_t)u.pm * 256 * 1024 + u.pn * 256, 1024, 0.0625f, false, wr, wc, fr, fq); }
};
struct EpiVWo {
    static constexpr bool PERM = true, AFTER_DRAIN = false, HAS_MID = false;
    bf16_t* VWOT;
    __device__ __forceinline__ void operator()(const AccT& acc, const Unit& u, int wr, int wc, int fr, int fq) const {
        store_tile_bf16(acc, VWOT + (size_t)(u.pn >> 2) * 1024 * 1024 + (size_t)u.pm * 256 * 1024 + (u.pn & 3) * 256, 1024, 1.f, false, wr, wc, fr, fq); }
};
struct EpiMerge {
    static constexpr bool PERM = true, AFTER_DRAIN = false, HAS_MID = true;
    const bf16_t* GDN; const bf16_t* GPOOL; bf16_t* MERGED;
    __device__ __forceinline__ void mid(AccT& acc, const Unit& u, int wr, int wc, int fr, int fq) const {
        unsigned rb = (unsigned)(u.pm * 256 + wr * 64 + fr); asm volatile("" : "+v"(rb));
        const size_t base = (size_t)rb * 1024 + u.pn * 256 + wc * 32 + 8 * fq;
#pragma unroll
        for (int ai = 0; ai < 2; ++ai)
#pragma unroll
            for (int m = 0; m < 4; ++m) {
#pragma unroll
                for (int bj = 0; bj < 2; ++bj) { const size_t off = base + (size_t)(ai * 128 + m * 16) * 1024 + bj * 128;
                    const u32x4 g1 = *(const u32x4*)(GDN + off), g2 = *(const u32x4*)(GPOOL + off); float a[8], b[8]; unpack8(g1, a); unpack8(g2, b);
#pragma unroll
                    for (int j = 0; j < 4; ++j) { acc[ai][bj][m][0][j] *= a[j] * __builtin_amdgcn_rcpf(fmaxf(b[j], 1e-30f)); acc[ai][bj][m][1][j] *= a[4 + j] * __builtin_amdgcn_rcpf(fmaxf(b[4 + j], 1e-30f)); }
                    asm volatile("" ::: "memory"); } }
    }
    __device__ __forceinline__ void operator()(const AccT& acc, const Unit& u, int wr, int wc, int fr, int fq) const {
        const size_t base = (size_t)(u.pm * 256 + wr * 64 + fr) * 1024 + u.pn * 256 + wc * 32 + 8 * fq;
#pragma unroll
        for (int ai = 0; ai < 2; ++ai)
#pragma unroll
            for (int m = 0; m < 4; ++m) {
#pragma unroll
                for (int bj = 0; bj < 2; ++bj) { const size_t off = base + (size_t)(ai * 128 + m * 16) * 1024 + bj * 128;
                    const u32x4 g2 = *(const u32x4*)(GPOOL + off); float b[8]; unpack8(g2, b);
                    const f32x4 v0 = acc[ai][bj][m][0], v1 = acc[ai][bj][m][1];
                    u32x4 w; w.x = cvt_pk_bf16(v0[0] * b[0], v0[1] * b[1]); w.y = cvt_pk_bf16(v0[2] * b[2], v0[3] * b[3]); w.z = cvt_pk_bf16(v1[0] * b[4], v1[1] * b[5]); w.w = cvt_pk_bf16(v1[2] * b[6], v1[3] * b[7]);
                    *(u32x4*)(MERGED + off) = w; }
                asm volatile("" ::: "memory"); }
    }
};
struct EpiSoftmax {
    static constexpr bool PERM = true, AFTER_DRAIN = true, HAS_MID = false;
    bf16_t* PB;
    __device__ __forceinline__ void fused(AccT& acc, const Unit& u, int wr, int wc, int fr, int fq, LAS unsigned char* lds, int wid, int lane) const {
        LAS f32x2* P = (LAS f32x2*)lds;
#pragma unroll
        for (int ai = 0; ai < 2; ++ai)
#pragma unroll
            for (int m = 0; m < 4; ++m) {
                float mx = -3.0e38f;
#pragma unroll
                for (int bj = 0; bj < 2; ++bj)
#pragma unroll
                    for (int n = 0; n < 2; ++n)
#pragma unroll
                        for (int j = 0; j < 4; ++j) mx = fmaxf(mx, acc[ai][bj][m][n][j]);
                mx = fmaxf(mx, __shfl_xor(mx, 16)); mx = fmaxf(mx, __shfl_xor(mx, 32));
                float s = 0.f;
#pragma unroll
                for (int bj = 0; bj < 2; ++bj)
#pragma unroll
                    for (int n = 0; n < 2; ++n)
#pragma unroll
                        for (int j = 0; j < 4; ++j) s += __expf(acc[ai][bj][m][n][j] - mx);
                s += __shfl_xor(s, 16); s += __shfl_xor(s, 32);
                if (fq == 0) P[(ai * 128 + wr * 64 + m * 16 + fr) * 4 + wc] = (f32x2){mx, s};
            }
        __syncthreads();
#pragma unroll
        for (int ai = 0; ai < 2; ++ai)
#pragma unroll
            for (int m = 0; m < 4; ++m) { const int r = ai * 128 + wr * 64 + m * 16 + fr;
                const f32x2 p0 = P[r * 4 + 0], p1 = P[r * 4 + 1], p2 = P[r * 4 + 2], p3 = P[r * 4 + 3];
                const float M = fmaxf(fmaxf(p0.x, p1.x), fmaxf(p2.x, p3.x));
                const float S = p0.y * __expf(p0.x - M) + p1.y * __expf(p1.x - M) + p2.y * __expf(p2.x - M) + p3.y * __expf(p3.x - M);
                const float inv = 1.0f / S;
                bf16_t* rowp = PB + (size_t)(u.pm * 256 + r) * 1024 + u.pn * 256 + wc * 32 + 8 * fq;
#pragma unroll
                for (int bj = 0; bj < 2; ++bj) { float v[8];
#pragma unroll
                    for (int j = 0; j < 4; ++j) { v[j] = __expf(acc[ai][bj][m][0][j] - M) * inv; v[4 + j] = __expf(acc[ai][bj][m][1][j] - M) * inv; }
                    *(u32x4*)(rowp + bj * 128) = pack8(v); } }
    }
};

template <int MODE>
__device__ __forceinline__ const float* tr_colptr(const float* s0, const float* s1, int n) {
    if (MODE == 0) return s0 + n;
    else if (MODE == 1) { const int w = n & 31, G = n >> 5; return ((w < 16) ? s0 : s1) + G * 16 + (w & 15); }
    else if (MODE == 2) return s0 + (n < 2048 ? n : n + 8);
    else return n < 1024 ? s0 + n : s1 + (n - 1024);
}
template <int MODE>
__device__ __forceinline__ void transpose_job(LAS float* tile, int K, int N, int src_ld, bf16_t* out, int out_ld, const float* s0, const float* s1, int rot) {
    const int tid = opaque_tid(), tk = K / 64, nt = tk * (N / 64);
    const int nl = tid & 63, kl = tid >> 6, nl2 = tid >> 3, ks = tid & 7;
    int t = (int)((blockIdx.x + rot) % gridDim.x);
    float r[8];
    if (t < nt) { const float* cp = tr_colptr<MODE>(s0, s1, (t / tk) * 64 + nl) + (size_t)((t % tk) * 64 + kl) * src_ld;
#pragma unroll
        for (int kk = 0; kk < 8; ++kk) r[kk] = cp[(size_t)kk * 8 * src_ld]; }
    for (; t < nt; t += gridDim.x) {
        const int k0 = (t % tk) * 64, n0 = (t / tk) * 64;
#pragma unroll
        for (int kk = 0; kk < 8; ++kk) tile[(kk * 8 + kl) * 65 + nl] = r[kk];
        const int tn = t + gridDim.x;
        if (tn < nt) { const float* cp = tr_colptr<MODE>(s0, s1, (tn / tk) * 64 + nl) + (size_t)((tn % tk) * 64 + kl) * src_ld;
#pragma unroll
            for (int kk = 0; kk < 8; ++kk) r[kk] = cp[(size_t)kk * 8 * src_ld]; }
        __syncthreads();
        { float v[8];
#pragma unroll
          for (int j = 0; j < 8; ++j) v[j] = tile[(ks * 8 + j) * 65 + nl2];
          *(u32x4*)(out + (size_t)(n0 + nl2) * out_ld + k0 + ks * 8) = pack8(v); }
        __syncthreads();
    }
}
__device__ __forceinline__ void convert_ffn_weights(LAS float* tile, const float* wg, const float* wu, const float* wd, unsigned char* ws) {
    transpose_job<1>(tile, 1024, 5632, FF, (bf16_t*)(ws + WS_FFNGU), 1024, wg, wu, 0);
    transpose_job<0>(tile, FF, 1024, 1024, (bf16_t*)(ws + WS_FFND), FF, wd, nullptr, 128);
}
__device__ __forceinline__ void ln_row(const float* src, const float* g, const float* b, int lane, f32x4 (&y)[4]) {
    f32x4 v[4];
#pragma unroll
    for (int j = 0; j < 4; ++j) v[j] = *(const f32x4*)(src + j * 256 + lane * 4);
    float s = 0.f;
#pragma unroll
    for (int j = 0; j < 4; ++j) s += (v[j][0] + v[j][1]) + (v[j][2] + v[j][3]);
    const float mean = wave_sum(s) * (1.0f / 1024.0f);
    float q = 0.f;
#pragma unroll
    for (int j = 0; j < 4; ++j) { const f32x4 d = v[j] - mean; q += (d[0] * d[0] + d[1] * d[1]) + (d[2] * d[2] + d[3] * d[3]); }
    const float rstd = 1.0f / sqrtf(wave_sum(q) * (1.0f / 1024.0f) + 1e-5f);
#pragma unroll
    for (int j = 0; j < 4; ++j) { const f32x4 gg = *(const f32x4*)(g + j * 256 + lane * 4), bb = *(const f32x4*)(b + j * 256 + lane * 4); y[j] = (v[j] - mean) * rstd * gg + bb; }
}
__device__ __forceinline__ void store_row_bf16(bf16_t* dst, int lane, const f32x4 (&y)[4]) {
#pragma unroll
    for (int j = 0; j < 4; ++j) { u32x2 w; w.x = cvt_pk_bf16(y[j][0], y[j][1]); w.y = cvt_pk_bf16(y[j][2], y[j][3]); *(u32x2*)(dst + j * 256 + lane * 4) = w; }
}
__device__ __forceinline__ void ln_phase(float* xio, bf16_t* xb, const float* g, const float* b) {
    const int tid = opaque_tid(), lane = tid & 63, wave = tid >> 6;
    for (int row = blockIdx.x * 8 + wave; row < MTOK; row += gridDim.x * 8) {
        f32x4 y[4]; ln_row(xio + (size_t)row * DM, g, b, lane, y);
#pragma unroll
        for (int j = 0; j < 4; ++j) *(f32x4*)(xio + (size_t)row * DM + j * 256 + lane * 4) = y[j];
        if (xb) store_row_bf16(xb + (size_t)row * DM, lane, y);
    }
}

__device__ __forceinline__ void dn_prep_unit(const KParams& P, LAS unsigned char* lds, int unit) {
    const int tid = opaque_tid(), lane = tid & 63, wave = tid >> 6;
    const int h = unit & 3, gchunk = unit >> 2, chunk = gchunk & 63; const size_t row0 = (size_t)gchunk * 64;
    bf16_t* qkvb = (bf16_t*)(P.ws + WS_QKVB); const bf16_t* halo = (const bf16_t*)(P.ws + WS_HALO);
    const float* garr = (const float*)(P.ws + WS_GARR); const float* betaarr = (const float*)(P.ws + WS_BETA);
    LAS unsigned char* KB16 = lds; LAS unsigned char* QB16 = lds + 17408; LAS unsigned char* KDT = lds + 34816;
    LAS float* RHS = (LAS float*)(lds + 53248); LAS float* AM = (LAS float*)(lds + 118784);
    LAS float* GC = (LAS float*)(lds + 135168); LAS float* BT = GC + 64;
    if (tid < 64) { float v = garr[(row0 + tid) * 4 + h];
#pragma unroll
        for (int off = 1; off < 64; off <<= 1) { const float t = __shfl_up(v, off); if (lane >= off) v += t; }
        GC[tid] = v; BT[tid] = betaarr[(row0 + tid) * 4 + h]; }
    __syncthreads();
    const int r = tid >> 3, seg = tid & 7, ch0 = seg * 16;
    const float gc_r = GC[r], beta_r = BT[r], gl = GC[63], egc_r = __expf(gc_r), ekd_r = __expf(gl - gc_r);
    float qn[16];
#pragma unroll
    for (int part = 0; part < 3; ++part) {
        const int col0 = part * 512 + h * 128 + ch0;
        float y[16];
#pragma unroll
        for (int c = 0; c < 16; ++c) y[c] = 0.f;
#pragma unroll
        for (int j = 0; j < 4; ++j) {
            const int tt = r - 3 + j; u32x4 w0 = (u32x4){0u, 0u, 0u, 0u}, w1 = w0;
            if (tt >= 0) { const bf16_t* p = qkvb + (row0 + tt) * 1536 + col0; w0 = *(const u32x4*)p; w1 = *(const u32x4*)(p + 8); }
            else if (chunk > 0) { const bf16_t* p = halo + (size_t)((gchunk - 1) * 3 + tt + 3) * 1536 + col0; w0 = *(const u32x4*)p; w1 = *(const u32x4*)(p + 8); }
            float x[16]; { float a[8], b[8]; unpack8(w0, a); unpack8(w1, b);
#pragma unroll
                for (int c = 0; c < 8; ++c) { x[c] = a[c]; x[8 + c] = b[c]; } }
            const float* cw = P.in[8] + j * 1536 + col0;
#pragma unroll
            for (int c4 = 0; c4 < 4; ++c4) { const f32x4 wv = *(const f32x4*)(cw + c4 * 4);
#pragma unroll
                for (int e = 0; e < 4; ++e) y[c4 * 4 + e] += wv[e] * x[c4 * 4 + e]; }
        }
        float ss = 0.f;
#pragma unroll
        for (int c = 0; c < 16; ++c) { y[c] = siluf_(y[c]); ss += y[c] * y[c]; }
        ss += __shfl_xor(ss, 1); ss += __shfl_xor(ss, 2); ss += __shfl_xor(ss, 4);
        if (part == 0) {
            const float sc = (1.0f / sqrtf(ss + 1e-6f)) * 0.08838834764831845f;
            float v[8];
#pragma unroll
            for (int c = 0; c < 16; ++c) qn[c] = y[c] * sc;
#pragma unroll
            for (int c = 0; c < 8; ++c) v[c] = qn[c];
            *(LAS u32x4*)(QB16 + r * 272 + ch0 * 2) = pack8(v);
#pragma unroll
            for (int c = 0; c < 8; ++c) v[c] = qn[8 + c];
            *(LAS u32x4*)(QB16 + r * 272 + ch0 * 2 + 16) = pack8(v);
        } else if (part == 1) {
            const float sc = 1.0f / sqrtf(ss + 1e-6f);
            float v[8];
#pragma unroll
            for (int c = 0; c < 16; ++c) y[c] *= sc;
#pragma unroll
            for (int c = 0; c < 8; ++c) v[c] = y[c];
            *(LAS u32x4*)(KB16 + r * 272 + ch0 * 2) = pack8(v);
#pragma unroll
            for (int c = 0; c < 8; ++c) v[c] = y[8 + c];
            *(LAS u32x4*)(KB16 + r * 272 + ch0 * 2 + 16) = pack8(v);
            const float bw = beta_r * egc_r;
#pragma unroll
            for (int c4 = 0; c4 < 4; ++c4) *(LAS f32x4*)(RHS + r * 256 + 128 + ch0 + c4 * 4) = (f32x4){y[c4 * 4] * bw, y[c4 * 4 + 1] * bw, y[c4 * 4 + 2] * bw, y[c4 * 4 + 3] * bw};
#pragma unroll
            for (int c = 0; c < 16; ++c) *(LAS bf16_t*)(KDT + (ch0 + c) * 144 + r * 2) = f2bf(y[c] * ekd_r);
        } else {
#pragma unroll
            for (int c4 = 0; c4 < 4; ++c4) *(LAS f32x4*)(RHS + r * 256 + ch0 + c4 * 4) = (f32x4){y[c4 * 4] * beta_r, y[c4 * 4 + 1] * beta_r, y[c4 * 4 + 2] * beta_r, y[c4 * 4 + 3] * beta_r};
        }
    }
    __syncthreads();
    {
        float v[8]; bf16_t* p = qkvb + (row0 + r) * 1536 + h * 128 + ch0;
#pragma unroll
        for (int c = 0; c < 8; ++c) v[c] = qn[c] * egc_r;
        *(u32x4*)p = pack8(v);
#pragma unroll
        for (int c = 0; c < 8; ++c) v[c] = qn[8 + c] * egc_r;
        *(u32x4*)(p + 8) = pack8(v);
    }
#pragma unroll
    for (int i = 0; i < 2; ++i) {
        const int idx = tid + i * 512, d = idx >> 3, pc = idx & 7;
        *(u32x4*)(qkvb + (row0 + (d >> 1)) * 1536 + 512 + h * 128 + (d & 1) * 64 + pc * 8) = *(const LAS u32x4*)(KDT + d * 144 + pc * 16);
    }
    {
        const int fr = lane & 15, fq = lane >> 4; const bool isA = wave < 4; const int ti = wave & 3;
        LAS unsigned char* X = isA ? KB16 : QB16;
        bf16_t* attb = (bf16_t*)(P.ws + WS_ATT) + (size_t)unit * 4096;
#pragma unroll
        for (int tj = 0; tj < 4; ++tj) {
            f32x4 acc = (f32x4){0.f, 0.f, 0.f, 0.f};
#pragma unroll
            for (int kk = 0; kk < 4; ++kk) {
                const bf16x8 a = *(const LAS bf16x8*)(X + (ti * 16 + fr) * 272 + (kk * 32 + fq * 8) * 2);
                const bf16x8 b = *(const LAS bf16x8*)(KB16 + (tj * 16 + fr) * 272 + (kk * 32 + fq * 8) * 2);
                acc = __builtin_amdgcn_mfma_f32_16x16x32_bf16(a, b, acc, 0, 0, 0);
            }
            const int jj = tj * 16 + fr; const float gcj = GC[jj];
#pragma unroll
            for (int j = 0; j < 4; ++j) { const int i = ti * 16 + fq * 4 + j; const float gci = GC[i];
                if (isA) AM[i * 64 + jj] = (i > jj) ? BT[i] * acc[j] * __expf(gci - gcj) : 0.f;
                else attb[i * 64 + jj] = f2bf((i >= jj) ? acc[j] * __expf(gci - gcj) : 0.f); }
        }
    }
    __syncthreads();
    if (tid < 256) {
        float sol[64]; int zv = 0; asm volatile("" : "+v"(zv));
        const LAS float* AMv = AM + zv;
#pragma unroll
        for (int i = 0; i < 64; ++i) {
            float s = RHS[i * 256 + tid];
#pragma unroll
            for (int j4 = 0; j4 < (i + 3) / 4; ++j4) { const f32x4 a = *(const LAS f32x4*)(AMv + i * 64 + j4 * 4);
#pragma unroll
                for (int e = 0; e < 4; ++e) if (j4 * 4 + e < i) s -= a[e] * sol[j4 * 4 + e]; }
            sol[i] = s;
        }
        if (tid < 128) {
#pragma unroll
            for (int i = 0; i < 64; ++i) qkvb[(row0 + i) * 1536 + 1024 + h * 128 + tid] = f2bf(sol[i]);
        } else { bf16_t* wb = (bf16_t*)(P.ws + WS_WBUF);
#pragma unroll
            for (int i = 0; i < 64; ++i) wb[(row0 + i) * 512 + h * 128 + (tid - 128)] = f2bf(sol[i]);
        }
    }
    if (tid == 0) ((float*)(P.ws + WS_GL))[unit * 32] = gl;
    __syncthreads();
}

__device__ __forceinline__ void dn_scan(const KParams& P, LAS unsigned char* lds) {
    if (blockIdx.x >= 128) return;
    const int tid = opaque_tid(), lane = tid & 63, wave = tid >> 6, fr = lane & 15, fq = lane >> 4;
    const int bh = blockIdx.x >> 3, es = blockIdx.x & 7, b = bh >> 2, h = bh & 3, e0 = es * 16;
    const bf16_t* qkvb = (const bf16_t*)(P.ws + WS_QKVB); const bf16_t* wbuf = (const bf16_t*)(P.ws + WS_WBUF);
    const bf16_t* attb = (const bf16_t*)(P.ws + WS_ATT); const float* glarr = (const float*)(P.ws + WS_GL);
    bf16_t* obuf = (bf16_t*)(P.ws + WS_O);
    constexpr int OFF_W = 0, OFF_QD = 17408, OFF_KDT = 34816, OFF_ATT = 53248, OFF_U = 62464, BUFSZ = 64512;
    LAS unsigned char* ST = lds + 2 * BUFSZ; LAS unsigned char* VNT = ST + 4352;
    for (int i = tid; i < 4352 / 4; i += NTHR) ((LAS unsigned*)ST)[i] = 0u;
    u32x4 rW[2], rQ[2], rK[2], rA, rU;
    const int wr_ = tid >> 4, wc_ = tid & 15;
    const int kd_ = tid >> 3, kp_ = tid & 7;
    const int ar_ = tid >> 3, ap_ = tid & 7;
    const int ur_ = tid >> 1, up_ = tid & 1;
#define SCAN_LOAD(n) do { const int gch = b * 64 + (n); const size_t r0 = (size_t)gch * 64; const int un = gch * 4 + h; \
        _Pragma("unroll") for (int i = 0; i < 2; ++i) { const int rr = wr_ + i * 32; \
            rW[i] = *(const u32x4*)(wbuf + (r0 + rr) * 512 + h * 128 + wc_ * 8); \
            rQ[i] = *(const u32x4*)(qkvb + (r0 + rr) * 1536 + h * 128 + wc_ * 8); \
            const int d = kd_ + i * 64; rK[i] = *(const u32x4*)(qkvb + (r0 + (d >> 1)) * 1536 + 512 + h * 128 + (d & 1) * 64 + kp_ * 8); } \
        rA = *(const u32x4*)(attb + (size_t)un * 4096 + ar_ * 64 + ap_ * 8); \
        if (tid < 128) rU = *(const u32x4*)(qkvb + (r0 + ur_) * 1536 + 1024 + h * 128 + e0 + up_ * 8); } while (0)
#define SCAN_STORE(buf) do { LAS unsigned char* B_ = lds + (buf) * BUFSZ; \
        _Pragma("unroll") for (int i = 0; i < 2; ++i) { const int rr = wr_ + i * 32; \
            *(LAS u32x4*)(B_ + OFF_W + rr * 272 + wc_ * 16) = rW[i]; *(LAS u32x4*)(B_ + OFF_QD + rr * 272 + wc_ * 16) = rQ[i]; \
            *(LAS u32x4*)(B_ + OFF_KDT + (kd_ + i * 64) * 144 + kp_ * 16) = rK[i]; } \
        *(LAS u32x4*)(B_ + OFF_ATT + ar_ * 144 + ap_ * 16) = rA; \
        if (tid < 128) *(LAS u32x4*)(B_ + OFF_U + ur_ * 32 + up_ * 16) = rU; } while (0)
    SCAN_LOAD(0); SCAN_STORE(0);
    __syncthreads();
    f32x4 sacc = (f32x4){0.f, 0.f, 0.f, 0.f};
    for (int n = 0; n < 64; ++n) {
        LAS unsigned char* B_ = lds + (n & 1) * BUFSZ;
        if (n + 1 < 64) SCAN_LOAD(n + 1);
        const float eg = __expf(glarr[((b * 64 + n) * 4 + h) * 32]);
        const int ct = wave & 3;
        f32x4 acc = (f32x4){0.f, 0.f, 0.f, 0.f};
        { LAS unsigned char* X = B_ + (wave < 4 ? OFF_W : OFF_QD);
#pragma unroll
          for (int kk = 0; kk < 4; ++kk) {
              const bf16x8 a = *(const LAS bf16x8*)(X + (ct * 16 + fr) * 272 + (kk * 32 + fq * 8) * 2);
              const bf16x8 s = *(const LAS bf16x8*)(ST + fr * 272 + (kk * 32 + fq * 8) * 2);
              acc = __builtin_amdgcn_mfma_f32_16x16x32_bf16(a, s, acc, 0, 0, 0); } }
        if (wave < 4) {
            float vn[4];
#pragma unroll
            for (int j = 0; j < 4; ++j) vn[j] = bf2f(*(const LAS bf16_t*)(B_ + OFF_U + (ct * 16 + fq * 4 + j) * 32 + fr * 2)) - acc[j];
            u32x2 w; w.x = cvt_pk_bf16(vn[0], vn[1]); w.y = cvt_pk_bf16(vn[2], vn[3]);
            *(LAS u32x2*)(VNT + fr * 144 + (ct * 16 + fq * 4) * 2) = w;
        }
        __syncthreads();
        if (wave >= 4) {
#pragma unroll
            for (int kk = 0; kk < 2; ++kk) {
                const bf16x8 a = *(const LAS bf16x8*)(B_ + OFF_ATT + (ct * 16 + fr) * 144 + (kk * 32 + fq * 8) * 2);
                const bf16x8 v = *(const LAS bf16x8*)(VNT + fr * 144 + (kk * 32 + fq * 8) * 2);
                acc = __builtin_amdgcn_mfma_f32_16x16x32_bf16(a, v, acc, 0, 0, 0); }
#pragma unroll
            for (int j = 0; j < 4; ++j) obuf[((size_t)(bh * 8 + es) * 4096 + n * 64 + ct * 16 + fq * 4 + j) * 16 + fr] = f2bf(acc[j]);
        }
        sacc *= eg;
#pragma unroll
        for (int kk = 0; kk < 2; ++kk) {
            const bf16x8 a = *(const LAS bf16x8*)(B_ + OFF_KDT + (wave * 16 + fr) * 144 + (kk * 32 + fq * 8) * 2);
            const bf16x8 v = *(const LAS bf16x8*)(VNT + fr * 144 + (kk * 32 + fq * 8) * 2);
            sacc = __builtin_amdgcn_mfma_f32_16x16x32_bf16(a, v, sacc, 0, 0, 0); }
        { u32x2 w; w.x = cvt_pk_bf16(sacc[0], sacc[1]); w.y = cvt_pk_bf16(sacc[2], sacc[3]);
          *(LAS u32x2*)(ST + fr * 272 + (wave * 16 + fq * 4) * 2) = w; }
        if (n + 1 < 64) SCAN_STORE((n + 1) & 1);
        __syncthreads();
    }
#undef SCAN_LOAD
#undef SCAN_STORE
}

#define GRID_SYNC() do { asm volatile("s_waitcnt vmcnt(0) lgkmcnt(0)" ::: "memory"); grid.sync(); if (threadIdx.x < 64) { __builtin_amdgcn_fence(__ATOMIC_ACQUIRE, "agent"); asm volatile("s_waitcnt vmcnt(0)" ::: "memory"); } __syncthreads(); } while (0)
__global__ void __launch_bounds__(NTHR) fwd_megakernel(KParams P) {
    extern __shared__ __attribute__((aligned(16))) unsigned char lds_raw[];
    LAS unsigned char* lds = (LAS unsigned char*)lds_raw;
    cg::grid_group grid = cg::this_grid();
    const int G = gridDim.x, bid = blockIdx.x;
    unsigned char* ws = P.ws;
    const float* x_in = P.in[0];
    float* xio = P.out;

    if (P.lo <= 0 && 0 <= P.hi) {
    {
        const int tid = opaque_tid(), lane = tid & 63, wave = tid >> 6;
        LAS float* tile = (LAS float*)lds;
        convert_ffn_weights(tile, P.in[2], P.in[3], P.in[4], ws);
        { const float* w = P.in[7];
          transpose_job<2>(tile, 1024, 4608, 4616, (bf16_t*)(ws + WS_WINT), 1024, w, nullptr, 64); }
        { const float* w = P.in[12]; transpose_job<0>(tile, 512, 1024, 1024, (bf16_t*)(ws + WS_CATW), 1024, w, nullptr, 32); }
        { const float* w = P.in[16]; transpose_job<0>(tile, 1024, 1024, 1024, (bf16_t*)(ws + WS_WMIXT), 1024, w, nullptr, 160); }
        { const float* wk = P.in[22]; const float* wv = P.in[23];
          transpose_job<3>(tile, 1024, 2048, 1024, (bf16_t*)(ws + WS_WKVT), 1024, wk, wv, 96); }
        { const float* w = P.in[24]; transpose_job<0>(tile, 1024, 1024, 1024, (bf16_t*)(ws + WS_WOT), 1024, w, nullptr, 224); }
        {
            const float* w = P.in[21]; bf16_t* o = (bf16_t*)(ws + WS_WQ);
            for (int i = bid * NTHR + tid; i < 1024 * 1024 / 8; i += G * NTHR) { const f32x4 a = *(const f32x4*)(w + (size_t)i * 8), b = *(const f32x4*)(w + (size_t)i * 8 + 4);
                u32x4 q; q.x = cvt_pk_bf16(a[0], a[1]); q.y = cvt_pk_bf16(a[2], a[3]); q.z = cvt_pk_bf16(b[0], b[1]); q.w = cvt_pk_bf16(b[2], b[3]); *(u32x4*)(o + (size_t)i * 8) = q; }
        }
        {
            const float* pw = P.in[13]; const float* sc = P.in[14]; const float* wpb = P.in[15]; bf16_t* o = (bf16_t*)(ws + WS_CATW);
            for (int idx = bid * NTHR + tid; idx < 65536; idx += G * NTHR) {
                const int n = (idx >> 3) & 1023, oct = (idx >> 13) * 8 + (idx & 7), gg = oct >> 4, c0 = (oct & 15) * 8;
                float a[8];
#pragma unroll
                for (int i = 0; i < 8; ++i) a[i] = 0.f;
#pragma unroll 8
                for (int d = 0; d < 128; ++d) { const float wv = wpb[(size_t)(gg * 128 + d) * 1024 + n] * sc[gg * 128 + d];
#pragma unroll
                    for (int i = 0; i < 8; ++i) a[i] += pw[(gg * 128 + c0 + i) * 128 + d] * wv; }
                *(u32x4*)(o + (size_t)n * 1024 + 512 + gg * 128 + c0) = pack8(a);
            }
        }
        {
            bf16_t* xb = (bf16_t*)(ws + WS_A);
            for (size_t i = (size_t)bid * NTHR + tid; i < (size_t)MTOK * DM / 8; i += (size_t)G * NTHR) { const f32x4 a = *(const f32x4*)(x_in + i * 8), b = *(const f32x4*)(x_in + i * 8 + 4);
                u32x4 q; q.x = cvt_pk_bf16(a[0], a[1]); q.y = cvt_pk_bf16(a[2], a[3]); q.z = cvt_pk_bf16(b[0], b[1]); q.w = cvt_pk_bf16(b[2], b[3]); *(u32x4*)(xb + i * 8) = q; }
        }
        for (int row = bid * 8 + wave; row < 1024; row += G * 8) { f32x4 y[4]; ln_row(P.in[1] + (size_t)row * DM, P.in[19], P.in[20], lane, y); store_row_bf16((bf16_t*)(ws + WS_MB) + (size_t)row * DM, lane, y); }
    }
    }
    if (P.lo <= 0 && 0 < P.hi) GRID_SYNC();

    if (P.lo <= 1 && 1 <= P.hi) {
    {
        DescPlain g{(const bf16_t*)(ws + WS_A), (const bf16_t*)(ws + WS_FFNGU), 1024, 1024, 1024, 30, 0};
        pg8::StaticOrder S; S.init(64, 22, G, bid); EpiSwiglu E{(bf16_t*)(ws + WS_H)};
        pg8::gemm_phase(lds, g, S, E);
        DescPlain g2{(const bf16_t*)(ws + WS_MB), (const bf16_t*)(ws + WS_WKVT), 1024, 1024, 1024, 30, 0};
        pg8::StaticOrder S2; S2.init(4, 8, G, G - 1 - bid); EpiKV E2{(bf16_t*)(ws + WS_KV)};
        pg8::gemm_phase(lds, g2, S2, E2);
    }
    }
    if (P.lo <= 1 && 1 < P.hi) GRID_SYNC();

    if (P.lo <= 2 && 2 <= P.hi) {
    {
        DescPlain g{(const bf16_t*)(ws + WS_H), (const bf16_t*)(ws + WS_FFND), FF, FF, FF, 30, 0};
        pg8::StaticOrder S; S.init(64, 4, G, bid); EpiResF32 E{x_in, xio, 0.5f};
        pg8::gemm_phase(lds, g, S, E);
    }
    }
    if (P.lo <= 2 && 2 < P.hi) GRID_SYNC();

    if (P.lo <= 3 && 3 <= P.hi) {
    {
        const int tid = opaque_tid(), lane = tid & 63, wave = tid >> 6;
        LAS float* wab = (LAS float*)lds;
        for (int i = tid; i < 8192; i += NTHR) wab[i] = P.in[7][(size_t)(i & 1023) * 4616 + 2048 + (i >> 10)];
        __syncthreads();
        bf16_t* xb = (bf16_t*)(ws + WS_A); float* garr = (float*)(ws + WS_GARR); float* betaarr = (float*)(ws + WS_BETA);
        for (int row = bid * 8 + wave; row < MTOK; row += G * 8) {
            f32x4 y[4]; ln_row(xio + (size_t)row * DM, P.in[5], P.in[6], lane, y);
#pragma unroll
            for (int j = 0; j < 4; ++j) *(f32x4*)(xio + (size_t)row * DM + j * 256 + lane * 4) = y[j];
            store_row_bf16(xb + (size_t)row * DM, lane, y);
            float s[8];
#pragma unroll
            for (int c = 0; c < 8; ++c) { float a = 0.f;
#pragma unroll
                for (int j = 0; j < 4; ++j) { const f32x4 wv = *(const LAS f32x4*)(wab + c * 1024 + j * 256 + lane * 4); a += (y[j][0] * wv[0] + y[j][1] * wv[1]) + (y[j][2] * wv[2] + y[j][3] * wv[3]); }
                s[c] = wave_sum(a); }
            if (lane < 4) {
                const float av = lane == 0 ? s[0] : lane == 1 ? s[1] : lane == 2 ? s[2] : s[3];
                const float bv = lane == 0 ? s[4] : lane == 1 ? s[5] : lane == 2 ? s[6] : s[7];
                const float xx = av + P.in[10][lane];
                const float sp = fmaxf(xx, 0.f) + log1pf(__expf(-fabsf(xx)));
                garr[(size_t)row * 4 + lane] = -__expf(P.in[9][lane]) * sp;
                betaarr[(size_t)row * 4 + lane] = 1.0f / (1.0f + __expf(-bv));
            }
        }
    }
    }
    if (P.lo <= 3 && 3 < P.hi) GRID_SYNC();

    if (P.lo <= 4 && 4 <= P.hi) {
    {
        DescPlain g{(const bf16_t*)(ws + WS_A), (const bf16_t*)(ws + WS_WINT), 1024, 1024, 1024, 30, 0};
        pg8::StaticOrder S; S.init(64, 18, G, bid); EpiWin E{ws};
        pg8::gemm_phase(lds, g, S, E);
        DescKQ g2{(const bf16_t*)(ws + WS_KV), (const bf16_t*)(ws + WS_WQ), 256, 2048, 1024};
        pg8::StaticOrder S2; S2.init(16, 4, G, G - 1 - bid); EpiKQ E2{(bf16_t*)(ws + WS_KQT)};
        pg8::gemm_phase(lds, g2, S2, E2);
        DescVWo g3{(const bf16_t*)(ws + WS_WOT), (const bf16_t*)(ws + WS_KV), 256, 1024, 2048};
        pg8::StaticOrder S3; S3.init(4, 16, G, G - 1 - bid - 64); EpiVWo E3{(bf16_t*)(ws + WS_VWOT)};
        pg8::gemm_phase(lds, g3, S3, E3);
    }
    }
    if (P.lo <= 4 && 4 < P.hi) GRID_SYNC();

    if (P.lo <= 5 && 5 <= P.hi) {
    {
        const int tid = opaque_tid();
        const bf16_t* pp = (const bf16_t*)(ws + WS_PP); bf16_t* cat = (bf16_t*)(ws + WS_A);
        for (int ch = bid; ch < 256; ch += G) {
            const int c = tid, win = 2 << (c >> 7), pos0 = (ch & 63) * 64; const size_t row0 = (size_t)ch * 64;
            float s = 0.f;
            for (int t = -(win - 1); t < 0; ++t) if (pos0 + t >= 0) s += bf2f(pp[(row0 + t) * 512 + c]);
            for (int t = 0; t < 64; ++t) {
                const float pv = bf2f(pp[(row0 + t) * 512 + c]); s += pv;
                const int pos = pos0 + t; const float cnt = (float)(pos + 1 < win ? pos + 1 : win);
                cat[(row0 + t) * 1024 + 512 + c] = f2bf(s / cnt - pv);
                if (pos - win + 1 >= 0) s -= bf2f(pp[(row0 + t - win + 1) * 512 + c]);
            }
        }
        for (int unit = bid; unit < 1024; unit += G) dn_prep_unit(P, lds, unit);
    }
    }
    if (P.lo <= 5 && 5 < P.hi) GRID_SYNC();

    if (P.lo <= 6 && 6 <= P.hi) {
    dn_scan(P, lds);
    }
    if (P.lo <= 6 && 6 < P.hi) GRID_SYNC();

    if (P.lo <= 7 && 7 <= P.hi) {
    {
        const int tid = opaque_tid(), lane = tid & 63, wave = tid >> 6;
        const bf16_t* ob = (const bf16_t*)(ws + WS_O); const bf16_t* zb = (const bf16_t*)(ws + WS_ZB); bf16_t* cat = (bf16_t*)(ws + WS_A);
        const float* nw = P.in[11] + (lane & 15) * 8;
        const f32x4 nw0 = *(const f32x4*)nw, nw1 = *(const f32x4*)(nw + 4);
        for (int row = bid * 8 + wave; row < MTOK; row += G * 8) {
            float o[8], z[8]; unpack8(*(const u32x4*)(ob + ((size_t)(((row >> 12) * 4 + (lane >> 4)) * 8 + ((lane & 15) >> 1)) * 4096 + (row & 4095)) * 16 + (lane & 1) * 8), o); unpack8(*(const u32x4*)(zb + (size_t)row * 512 + lane * 8), z);
            float ss = 0.f;
#pragma unroll
            for (int i = 0; i < 8; ++i) ss += o[i] * o[i];
            ss += __shfl_xor(ss, 1); ss += __shfl_xor(ss, 2); ss += __shfl_xor(ss, 4); ss += __shfl_xor(ss, 8);
            const float rs = 1.0f / sqrtf(ss * (1.0f / 128.0f) + 1e-6f);
            float v[8];
#pragma unroll
            for (int i = 0; i < 8; ++i) v[i] = o[i] * rs * (i < 4 ? nw0[i & 3] : nw1[i & 3]) * siluf_(z[i]);
            *(u32x4*)(cat + (size_t)row * 1024 + lane * 8) = pack8(v);
        }
    }
    }
    if (P.lo <= 7 && 7 < P.hi) GRID_SYNC();

    if (P.lo <= 8 && 8 <= P.hi) {
    {
        DescPlain g{(const bf16_t*)(ws + WS_A), (const bf16_t*)(ws + WS_CATW), 1024, 1024, 1024, 30, 0};
        pg8::StaticOrder S; S.init(64, 4, G, bid); EpiMerge E{(const bf16_t*)(ws + WS_G), (const bf16_t*)(ws + WS_G + 32 * MiB), (bf16_t*)(ws + WS_MERGED)};
        pg8::gemm_phase(lds, g, S, E);
    }
    }
    if (P.lo <= 8 && 8 < P.hi) GRID_SYNC();

    if (P.lo <= 9 && 9 <= P.hi) {
    {
        DescPlain g{(const bf16_t*)(ws + WS_MERGED), (const bf16_t*)(ws + WS_WMIXT), 1024, 1024, 1024, 30, 0};
        pg8::StaticOrder S; S.init(64, 4, G, bid); EpiResF32 E{xio, xio, 1.0f};
        pg8::gemm_phase(lds, g, S, E);
    }
    }
    if (P.lo <= 9 && 9 < P.hi) GRID_SYNC();

    if (P.lo <= 10 && 10 <= P.hi) {
    ln_phase(xio, (bf16_t*)(ws + WS_A), P.in[17], P.in[18]);
    __syncthreads();
    convert_ffn_weights((LAS float*)lds, P.in[27], P.in[28], P.in[29], ws);
    }
    if (P.lo <= 10 && 10 < P.hi) GRID_SYNC();

    if (P.lo <= 11 && 11 <= P.hi) {
    {
        DescPlain g{(const bf16_t*)(ws + WS_A), (const bf16_t*)(ws + WS_KQT), 1024, 1024, 1024, 4, (size_t)1024 * 1024};
        pg8::StaticOrder S; S.init(64, 4, G, bid); EpiSoftmax E{(bf16_t*)(ws + WS_PB)};
        pg8::gemm_phase(lds, g, S, E);
    }
    }
    if (P.lo <= 11 && 11 < P.hi) GRID_SYNC();

    if (P.lo <= 12 && 12 <= P.hi) {
    {
        DescPlain g{(const bf16_t*)(ws + WS_PB), (const bf16_t*)(ws + WS_VWOT), 1024, 1024, 1024, 4, (size_t)1024 * 1024};
        pg8::StaticOrder S; S.init(64, 4, G, bid); EpiResF32 E{xio, xio, 1.0f};
        pg8::gemm_phase(lds, g, S, E);
    }
    }
    if (P.lo <= 12 && 12 < P.hi) GRID_SYNC();

    if (P.lo <= 13 && 13 <= P.hi) {
    ln_phase(xio, (bf16_t*)(ws + WS_A), P.in[25], P.in[26]);
    }
    if (P.lo <= 13 && 13 < P.hi) GRID_SYNC();

    if (P.lo <= 14 && 14 <= P.hi) {
    {
        DescPlain g{(const bf16_t*)(ws + WS_A), (const bf16_t*)(ws + WS_FFNGU), 1024, 1024, 1024, 30, 0};
        pg8::StaticOrder S; S.init(64, 22, G, bid); EpiSwiglu E{(bf16_t*)(ws + WS_H)};
        pg8::gemm_phase(lds, g, S, E);
    }
    }
    if (P.lo <= 14 && 14 < P.hi) GRID_SYNC();

    if (P.lo <= 15 && 15 <= P.hi) {
    {
        DescPlain g{(const bf16_t*)(ws + WS_H), (const bf16_t*)(ws + WS_FFND), FF, FF, FF, 30, 0};
        pg8::StaticOrder S; S.init(64, 4, G, bid); EpiResF32 E{xio, xio, 0.5f};
        pg8::gemm_phase(lds, g, S, E);
    }
    }
    if (P.lo <= 15 && 15 < P.hi) GRID_SYNC();

    if (P.lo <= 16 && 16 <= P.hi) {
    ln_phase(xio, nullptr, P.in[30], P.in[31]);
    }
}

extern "C" void kernel_launch(void* const* d_in, const int* in_sizes, int n_in, void* d_out, int out_size, void* d_ws, size_t ws_size, hipStream_t stream) {
    static int grid_blocks = 0;
    if (!grid_blocks) {
        int dev = 0, cus = 0, per_cu = 0;
        hipGetDevice(&dev);
        hipDeviceGetAttribute(&cus, hipDeviceAttributeMultiprocessorCount, dev);
        if (hipFuncSetAttribute((const void*)fwd_megakernel, hipFuncAttributeMaxDynamicSharedMemorySize, LDS_BYTES) != hipSuccess) fprintf(stderr, "kernel_launch: hipFuncSetAttribute failed\n");
        if (hipOccupancyMaxActiveBlocksPerMultiprocessor(&per_cu, (const void*)fwd_megakernel, NTHR, LDS_BYTES) != hipSuccess || per_cu < 1) { fprintf(stderr, "kernel_launch: occupancy query gave %d\n", per_cu); per_cu = 1; }
        (void)hipGetLastError();
        grid_blocks = cus * per_cu;
        if (ws_size < WS_END) fprintf(stderr, "kernel_launch: workspace too small: %zu < %zu\n", ws_size, (size_t)WS_END);
    }
    KParams p{};
    for (int i = 0; i < 32; ++i) p.in[i] = (const float*)d_in[i];
    p.out = (float*)d_out; p.ws = (unsigned char*)d_ws;
    void* args[] = {&p};
    hipError_t e = hipSuccess;
#if PER_PHASE_LAUNCH
    for (int ph = 0; ph < 17 && e == hipSuccess; ++ph) { p.lo = ph; p.hi = ph;
        e = hipLaunchCooperativeKernel((const void*)fwd_megakernel, dim3(grid_blocks), dim3(NTHR), args, LDS_BYTES, stream); }
#else
    p.lo = 0; p.hi = 16;
    e = hipLaunchCooperativeKernel((const void*)fwd_megakernel, dim3(grid_blocks), dim3(NTHR), args, LDS_BYTES, stream);
#endif
    if (e != hipSuccess) fprintf(stderr, "cooperative launch failed: %s (grid %d)\n", hipGetErrorString(e), grid_blocks);
}
```
